# Optimizing an MI355X kernel written in HIP

```python
import jax, jax.numpy as jnp
from jax import lax
import numpy as np

D_MODEL = 1024
BATCH = 8
SEQ = 4096
DEPTH = 1

GRID_W = 64
Q_BLOCK = 128
ROPE_THETA = 10000.0
EPS = 1e-6

MLA_HEADS = 8
MLA_NOPE_DIM = 64
MLA_ROPE_DIM = 32
MLA_V_DIM = 64
Q_LORA_RANK = 256
KV_LORA_RANK = 128

GQA_HEADS = 8
GQA_KV_HEADS = 2
GQA_HEAD_DIM = 64

IN_COLS = (Q_LORA_RANK, KV_LORA_RANK, MLA_ROPE_DIM,
           GQA_HEADS * GQA_HEAD_DIM, GQA_KV_HEADS * GQA_HEAD_DIM, GQA_KV_HEADS * GQA_HEAD_DIM)
D_IN = sum(IN_COLS)
MLA_OUT = MLA_HEADS * MLA_V_DIM
GQA_OUT = GQA_HEADS * GQA_HEAD_DIM
D_MIX = MLA_OUT + GQA_OUT

D_FF = 2816
N_MOD = 9

kernel_name = "hybrid_mla_gqa_macaron_adaln_encoder"


def rms_norm(x, g):
    xf = x.astype(jnp.float32)
    y = xf * lax.rsqrt(jnp.mean(xf * xf, axis=-1, keepdims=True) + EPS)
    return (y * g.astype(jnp.float32)).astype(x.dtype)


def modulate(h, shift, scale):
    return h * (1 + scale[:, None, :]) + shift[:, None, :]


def swiglu(h, w_gu, w_down):
    a, b = jnp.split(h @ w_gu, 2, axis=-1)
    return (jax.nn.silu(a) * b) @ w_down


def axial_angles(seq_len, dim):
    rows = seq_len // GRID_W
    row = jnp.repeat(jnp.arange(rows), GRID_W).astype(jnp.float32)
    col = jnp.tile(jnp.arange(GRID_W), rows).astype(jnp.float32)
    axis_dim = dim // 2
    inv_freq = ROPE_THETA ** (-(jnp.arange(axis_dim // 2, dtype=jnp.float32) * 2.0 / axis_dim))
    return row[:, None] * inv_freq[None, :], col[:, None] * inv_freq[None, :]


def rotate(x, ang):
    xf = x.astype(jnp.float32)
    x1, x2 = jnp.split(xf, 2, axis=-1)
    cos = jnp.cos(ang)[None, :, None, :]
    sin = jnp.sin(ang)[None, :, None, :]
    return jnp.concatenate([x1 * cos - x2 * sin, x1 * sin + x2 * cos], axis=-1).astype(x.dtype)


def axial_rope(x):
    seq_len, dim = x.shape[1], x.shape[-1]
    ang_row, ang_col = axial_angles(seq_len, dim)
    half = dim // 2
    return jnp.concatenate([rotate(x[..., :half], ang_row), rotate(x[..., half:], ang_col)], axis=-1)


def blocked_attention(q, k, v, scale):
    B, S, Hk, G, dk = q.shape
    nb = S // Q_BLOCK
    qb = q.reshape(B, nb, Q_BLOCK, Hk, G, dk).transpose(1, 0, 2, 3, 4, 5)

    def one_block(qi):
        s = jnp.einsum('bqhgd,bshd->bhgqs', qi, k).astype(jnp.float32) * scale
        p = jax.nn.softmax(s, axis=-1).astype(v.dtype)
        return jnp.einsum('bhgqs,bshe->bqhge', p, v)

    o = lax.map(one_block, qb)
    return o.transpose(1, 0, 2, 3, 4, 5).reshape(B, S, Hk * G * v.shape[-1])


def mla_group(q_lat, kv_lat, k_rope, g_q_lat, w_uq, g_kv_lat, w_ukv):
    B, S, _ = q_lat.shape
    q = (rms_norm(q_lat, g_q_lat) @ w_uq).reshape(B, S, MLA_HEADS, MLA_NOPE_DIM + MLA_ROPE_DIM)
    q_nope, q_pe = q[..., :MLA_NOPE_DIM], q[..., MLA_NOPE_DIM:]
    kv = (rms_norm(kv_lat, g_kv_lat) @ w_ukv).reshape(B, S, MLA_HEADS, MLA_NOPE_DIM + MLA_V_DIM)
    k_nope, v = kv[..., :MLA_NOPE_DIM], kv[..., MLA_NOPE_DIM:]
    q_pe = axial_rope(q_pe)
    k_pe = axial_rope(k_rope.reshape(B, S, 1, MLA_ROPE_DIM))
    q_full = jnp.concatenate([q_nope, q_pe], axis=-1)[:, :, :, None, :]
    k_full = jnp.concatenate([k_nope, jnp.broadcast_to(k_pe, (B, S, MLA_HEADS, MLA_ROPE_DIM))], axis=-1)
    return blocked_attention(q_full, k_full, v, (MLA_NOPE_DIM + MLA_ROPE_DIM) ** -0.5)


def gqa_group(q_in, k_in, v_in, g_qhead, g_khead):
    B, S, _ = q_in.shape
    q = axial_rope(rms_norm(q_in.reshape(B, S, GQA_HEADS, GQA_HEAD_DIM), g_qhead))
    k = axial_rope(rms_norm(k_in.reshape(B, S, GQA_KV_HEADS, GQA_HEAD_DIM), g_khead))
    v = v_in.reshape(B, S, GQA_KV_HEADS, GQA_HEAD_DIM)
    q = q.reshape(B, S, GQA_KV_HEADS, GQA_HEADS // GQA_KV_HEADS, GQA_HEAD_DIM)
    return blocked_attention(q, k, v, GQA_HEAD_DIM ** -0.5)


def setup_inputs(seed: int = 0) -> dict:
    key = jax.random.key(seed)
    ks = jax.random.split(key, 24)
    D, L = D_MODEL, DEPTH

    def w(k, shape, fan_in, mult=1.0):
        return jax.random.normal(k, shape, jnp.float32) * (fan_in ** -0.5) * mult

    def gain(k, shape):
        return 1.0 + 0.02 * jax.random.normal(k, shape, jnp.float32)

    return {
        "x": jax.random.normal(ks[0], (BATCH, SEQ, D), jnp.float32),
        "c": jax.random.normal(ks[1], (BATCH, D), jnp.float32),
        "w_ada": w(ks[2], (L, D, N_MOD * D), D, 0.5),
        "b_ada": 0.02 * jax.random.normal(ks[3], (L, N_MOD * D), jnp.float32),
        "g_ffn1": gain(ks[4], (L, D)),
        "w1_gu": w(ks[5], (L, D, 2 * D_FF), D),
        "w1_down": w(ks[6], (L, D_FF, D), D_FF),
        "g_mix": gain(ks[7], (L, D)),
        "w_in": w(ks[8], (L, D, D_IN), D),
        "g_q_lat": gain(ks[9], (L, Q_LORA_RANK)),
        "w_uq": w(ks[10], (L, Q_LORA_RANK, MLA_HEADS * (MLA_NOPE_DIM + MLA_ROPE_DIM)), Q_LORA_RANK),
        "g_kv_lat": gain(ks[11], (L, KV_LORA_RANK)),
        "w_ukv": w(ks[12], (L, KV_LORA_RANK, MLA_HEADS * (MLA_NOPE_DIM + MLA_V_DIM)), KV_LORA_RANK),
        "g_qhead": gain(ks[13], (L, GQA_HEAD_DIM)),
        "g_khead": gain(ks[14], (L, GQA_HEAD_DIM)),
        "g_out_mla": gain(ks[15], (L, MLA_OUT)),
        "g_out_gqa": gain(ks[16], (L, GQA_OUT)),
        "w_out": w(ks[17], (L, D_MIX, D), D_MIX),
        "g_ffn2": gain(ks[18], (L, D)),
        "w2_gu": w(ks[19], (L, D, 2 * D_FF), D),
        "w2_down": w(ks[20], (L, D_FF, D), D_FF),
        "g_final": gain(ks[21], (D,)),
    }


def reference(x, c, w_ada, b_ada, g_ffn1, w1_gu, w1_down, g_mix, w_in, g_q_lat, w_uq,
              g_kv_lat, w_ukv, g_qhead, g_khead, g_out_mla, g_out_gqa, w_out,
              g_ffn2, w2_gu, w2_down, g_final):
    offs = [int(o) for o in np.cumsum(IN_COLS)[:-1]]
    c_act = jax.nn.silu(c)
    for l in range(DEPTH):
        mod = c_act @ w_ada[l] + b_ada[l]
        (sh_f1, sc_f1, gt_f1, sh_m, sc_m, gt_m, sh_f2, sc_f2, gt_f2) = jnp.split(mod, N_MOD, axis=-1)

        h = modulate(rms_norm(x, g_ffn1[l]), sh_f1, sc_f1)
        x = x + 0.5 * gt_f1[:, None, :] * swiglu(h, w1_gu[l], w1_down[l])

        h = modulate(rms_norm(x, g_mix[l]), sh_m, sc_m)
        z = h @ w_in[l]
        q_lat, kv_lat, k_rope, q_g, k_g, v_g = jnp.split(z, offs, axis=-1)
        o_mla = mla_group(q_lat, kv_lat, k_rope, g_q_lat[l], w_uq[l], g_kv_lat[l], w_ukv[l])
        o_gqa = gqa_group(q_g, k_g, v_g, g_qhead[l], g_khead[l])
        o = jnp.concatenate([rms_norm(o_mla, g_out_mla[l]), rms_norm(o_gqa, g_out_gqa[l])], axis=-1)
        x = x + gt_m[:, None, :] * (o @ w_out[l])

        h = modulate(rms_norm(x, g_ffn2[l]), sh_f2, sc_f2)
        x = x + 0.5 * gt_f2[:, None, :] * swiglu(h, w2_gu[l], w2_down[l])
    return rms_norm(x, g_final)
```

```cpp
#include <hip/hip_runtime.h>
#include <hip/hip_cooperative_groups.h>
#include <cstdio>
#include <cstdint>
namespace cg = cooperative_groups;

namespace pg8 {
#define PG8_LAS __attribute__((address_space(3)))
typedef unsigned short bf16_t;
typedef short bf16x8 __attribute__((ext_vector_type(8)));
typedef float f32x4 __attribute__((ext_vector_type(4)));
typedef unsigned u32x4 __attribute__((ext_vector_type(4)));
constexpr int BM = 256, BK = 64, HALF = 128, HTB = HALF * BK * 2  , STAGE_BYTES = 8 * HTB, NXCD = 8, WGM = 8;

__host__ __device__ __forceinline__ int lds_byte(int r, int c) { const int st = (r >> 4) * 2 + (c >> 5), rr = r & 15, cc = c & 31, ob = rr * 64 + cc * 2; return st * 1024 + (ob ^ (((ob >> 9) & 1) << 5)); }
__host__ __device__ __forceinline__ void stage_rc(int b, int& R, int& C) { const int st = b / 1024, sb = b % 1024, swz = sb ^ (((sb >> 9) & 1) << 5); R = (st >> 1) * 16 + swz / 64; C = (st & 1) * 32 + (swz % 64) / 2; }
__host__ __device__ __forceinline__ int perm32(int rho) { const int n = rho >> 4, i = rho & 15; return 8 * (i >> 2) + 4 * n + (i & 3); }

struct Unit { int pm, pn; };
struct Gemm { const bf16_t* A; const bf16_t* Bt; int M, N, K; };

struct StaticOrder {
    int nM, nN, nwg, G, c;
    __host__ __device__ void init(int M, int N, int G_, int c_) { nM = M / BM; nN = N / BM; nwg = nM * nN; G = G_; c = c_; }
    __host__ __device__ bool next(int i, Unit& u) const {
        const long L = (long)i * G + c; if (L >= nwg) return false;
        int wgid = (int)L; { const int q = nwg / NXCD, r = nwg % NXCD, xcd = wgid % NXCD, off = wgid / NXCD; wgid = (xcd < r ? xcd * (q + 1) : r * (q + 1) + (xcd - r) * q) + off; }
        const int nig = WGM * nN, gid = wgid / nig, fm = gid * WGM, gsz = (nM - fm) < WGM ? (nM - fm) : WGM;
        u.pm = fm + ((wgid % nig) % gsz); u.pn = (wgid % nig) / gsz; return true;
    }
    __device__ __forceinline__ void a_ready(const Unit&) const {}
    __device__ __forceinline__ void done(const Unit&) const {}
};

typedef float f32x2c_t __attribute__((ext_vector_type(2))); typedef __bf16 bf16x2c_t __attribute__((ext_vector_type(2)));
__device__ __forceinline__ unsigned cvt_pk_bf16(float lo, float hi) { f32x2c_t v = {lo, hi}; bf16x2c_t b = __builtin_convertvector(v, bf16x2c_t); return __builtin_bit_cast(unsigned, b); }
typedef unsigned u32x2 __attribute__((ext_vector_type(2)));
constexpr int MTOK = 32768, SEQL = 4096, NMODC = 9216;
constexpr float NEPS = 1e-6f;
constexpr float C2M = 0.10206207261596577f * 1.4426950408889634f;
constexpr float C2G = 0.125f * 1.4426950408889634f;
__device__ __forceinline__ unsigned short bf1(float v) { return (unsigned short)(cvt_pk_bf16(v, 0.f) & 0xffffu); }
typedef float f32x2s __attribute__((ext_vector_type(2)));
__device__ __forceinline__ unsigned swi2(float a0, float a1, float b0, float b1) {
    const f32x2s a = {a0, a1}, b = {b0, b1};
    f32x2s e; e.x = __builtin_amdgcn_exp2f(-a.x); e.y = __builtin_amdgcn_exp2f(-a.y);
    const f32x2s d = e + 1.0f; f32x2s r; r.x = __builtin_amdgcn_rcpf(d.x); r.y = __builtin_amdgcn_rcpf(d.y);
    const f32x2s o = (a * b) * r;
    return cvt_pk_bf16(o.x, o.y);
}
__device__ __forceinline__ float dot4(f32x4 v) { return (v[0] * v[0] + v[1] * v[1]) + (v[2] * v[2] + v[3] * v[3]); }
__device__ __forceinline__ float quad_sum(float s) { s += __shfl_xor(s, 16); s += __shfl_xor(s, 32); return s; }
__device__ __forceinline__ void st4(bf16_t* p, f32x4 v) { u32x2 w; w.x = cvt_pk_bf16(v[0], v[1]); w.y = cvt_pk_bf16(v[2], v[3]); *(u32x2*)p = w; }

struct EpiSwiglu {
    static constexpr bool PERM = true, AFTER_DRAIN = false; static constexpr int MIDT = -1;
    bf16_t* O;
    __device__ __forceinline__ void mid(f32x4 (&)[2][2][4][2], const Unit&, int, int) const {}
    __device__ __forceinline__ void operator()(const f32x4 (&acc)[2][2][4][2], const Unit& u, int wr, int wc, int fr, int fq) const {
        asm volatile("" : "+v"(fr), "+v"(fq));
        const int row0 = u.pm * BM + wr * 64 + fr, col0 = u.pn * 128 + wc * 32 + 8 * fq;
#pragma unroll
        for (int ai = 0; ai < 2; ++ai)
#pragma unroll
            for (int m = 0; m < 4; ++m) {
                bf16_t* rowp = O + (size_t)(row0 + ai * HALF + m * 16) * 2816 + col0;
                const f32x4 a0 = acc[ai][0][m][0], a1 = acc[ai][0][m][1], b0 = acc[ai][1][m][0], b1 = acc[ai][1][m][1];
                u32x4 w;
                w.x = swi2(a0[0], a0[1], b0[0], b0[1]); w.y = swi2(a0[2], a0[3], b0[2], b0[3]);
                w.z = swi2(a1[0], a1[1], b1[0], b1[1]); w.w = swi2(a1[2], a1[3], b1[2], b1[3]);
                *(u32x4*)rowp = w;
            }
    }
};
__device__ __forceinline__ f32x4 bf4_lo(u32x4 w) { return (f32x4){__uint_as_float(w.x << 16), __uint_as_float(w.x & 0xffff0000u), __uint_as_float(w.y << 16), __uint_as_float(w.y & 0xffff0000u)}; }
__device__ __forceinline__ f32x4 bf4_hi(u32x4 w) { return (f32x4){__uint_as_float(w.z << 16), __uint_as_float(w.z & 0xffff0000u), __uint_as_float(w.w << 16), __uint_as_float(w.w & 0xffff0000u)}; }
template <bool MIX, bool XF32> struct EpiResid {
    static constexpr bool PERM = true, AFTER_DRAIN = false; static constexpr int MIDT = MIX ? 8 : -1;
    const void* xin; bf16_t* xout; const float* gate; const float* rs2;
    __device__ __forceinline__ void mid(f32x4 (&acc)[2][2][4][2], const Unit& u, int wr, int fr) const {
        if constexpr (MIX) {
#pragma unroll
            for (int ai = 0; ai < 2; ++ai)
#pragma unroll
                for (int m = 0; m < 4; ++m) { const int row = u.pm * BM + wr * 64 + fr + ai * HALF + m * 16; const f32x4 sq = *(const f32x4*)(rs2 + 4 * row); const float q = sqrtf(((sq[2] + sq[3]) * (1.f / 512.f) + NEPS) / ((sq[0] + sq[1]) * (1.f / 512.f) + NEPS));
#pragma unroll
                    for (int bj = 0; bj < 2; ++bj)
#pragma unroll
                        for (int n = 0; n < 2; ++n) acc[ai][bj][m][n] *= q; }
        }
    }
    __device__ __forceinline__ void operator()(const f32x4 (&acc)[2][2][4][2], const Unit& u, int wr, int wc, int fr, int fq) const {
        asm volatile("" : "+v"(fr), "+v"(fq));
        const int row0 = u.pm * BM + wr * 64 + fr, col0 = u.pn * BM + wc * 32 + 8 * fq, b = u.pm >> 4;
        f32x4 gv[2][2];
#pragma unroll
        for (int bj = 0; bj < 2; ++bj)
#pragma unroll
            for (int n = 0; n < 2; ++n) gv[bj][n] = *(const f32x4*)(gate + (size_t)b * NMODC + col0 + bj * HALF + n * 4) * (MIX ? 1.0f : 0.5f);
#pragma unroll
        for (int ai = 0; ai < 2; ++ai)
#pragma unroll
            for (int m = 0; m < 4; ++m) { const int row = row0 + ai * HALF + m * 16; const size_t off = (size_t)row * 1024 + col0; float rs = 1.f; if constexpr (MIX) { const float* sp = rs2 + 4 * row + 2; rs = 1.0f / sqrtf((sp[0] + sp[1]) * (1.f / 512.f) + NEPS); }
#pragma unroll
                for (int bj = 0; bj < 2; ++bj) { f32x4 x0, x1;
                    if constexpr (XF32) { x0 = *(const f32x4*)((const float*)xin + off + bj * HALF); x1 = *(const f32x4*)((const float*)xin + off + bj * HALF + 4); }
                    else { const u32x4 w = *(const u32x4*)((const bf16_t*)xin + off + bj * HALF); x0 = bf4_lo(w); x1 = bf4_hi(w); }
                    const f32x4 o0 = x0 + gv[bj][0] * (acc[ai][bj][m][0] * rs), o1 = x1 + gv[bj][1] * (acc[ai][bj][m][1] * rs);
                    u32x4 w; w.x = cvt_pk_bf16(o0[0], o0[1]); w.y = cvt_pk_bf16(o0[2], o0[3]); w.z = cvt_pk_bf16(o1[0], o1[1]); w.w = cvt_pk_bf16(o1[2], o1[3]);
                    *(u32x4*)(xout + off + bj * HALF) = w; } }
    }
};
__device__ __forceinline__ void rope4(f32x4 x1, f32x4 x2, const float* cs, f32x4& y1, f32x4& y2) {
    const f32x4 t0 = *(const f32x4*)cs, t1 = *(const f32x4*)(cs + 4);
    const f32x4 c = {t0[0], t0[2], t1[0], t1[2]}, s = {t0[1], t0[3], t1[1], t1[3]};
    y1 = x1 * c - x2 * s; y2 = x1 * s + x2 * c;
}
struct EpiWin {
    static constexpr bool PERM = false, AFTER_DRAIN = false; static constexpr int MIDT = -1;
    bf16_t *ZQ, *ZKV, *KPE, *QG, *KG, *VTG; float *SSQQ, *SSQKV; const float *gq, *gk, *ropeM, *ropeG;
    __device__ __forceinline__ void mid(f32x4 (&)[2][2][4][2], const Unit&, int, int) const {}
    __device__ __forceinline__ void operator()(const f32x4 (&acc)[2][2][4][2], const Unit& u, int wr, int wc, int fr, int fq) const {
        asm volatile("" : "+v"(fr), "+v"(fq));
        const int row0 = u.pm * BM + wr * 64 + fr;
        if (u.pn == 0) {
#pragma unroll
            for (int ai = 0; ai < 2; ++ai)
#pragma unroll
                for (int m = 0; m < 4; ++m) { const int row = row0 + ai * HALF + m * 16; float s = 0.f;
#pragma unroll
                    for (int bj = 0; bj < 2; ++bj)
#pragma unroll
                        for (int n = 0; n < 2; ++n) { const f32x4 v = acc[ai][bj][m][n]; s += dot4(v); st4(ZQ + (size_t)row * 256 + bj * HALF + wc * 32 + n * 16 + 4 * fq, v); }
                    s = quad_sum(s); if (fq == 0) SSQQ[row * 4 + wc] = s; }
        } else if (u.pn <= 2 || (u.pn == 3 && wc < 2)) {
            const bool isq = u.pn <= 2; const float* g = isq ? gq : gk;
            bf16_t* dst = isq ? QG + (4 * (u.pn - 1) + wc) * 64 : KG + wc * 64; const int pitch = isq ? 512 : 128; const float osc = isq ? C2G : 1.f;
            f32x4 gv[2][2];
#pragma unroll
            for (int bj = 0; bj < 2; ++bj)
#pragma unroll
                for (int n = 0; n < 2; ++n) gv[bj][n] = *(const f32x4*)(g + 32 * bj + 16 * n + 4 * fq) * osc;
#pragma unroll
            for (int ai = 0; ai < 2; ++ai)
#pragma unroll
                for (int m = 0; m < 4; ++m) { const int row = row0 + ai * HALF + m * 16; float s = 0.f;
#pragma unroll
                    for (int bj = 0; bj < 2; ++bj)
#pragma unroll
                        for (int n = 0; n < 2; ++n) s += dot4(acc[ai][bj][m][n]);
                    s = quad_sum(s); const float rstd = 1.0f / sqrtf(s * (1.f / 64.f) + NEPS);
                    const int srow = row & (SEQL - 1), prow = srow >> 6, pcol = srow & 63;
#pragma unroll
                    for (int bj = 0; bj < 2; ++bj) { const int pos = bj ? pcol : prow; f32x4 y1, y2;
                        rope4(acc[ai][bj][m][0] * rstd * gv[bj][0], acc[ai][bj][m][1] * rstd * gv[bj][1], ropeG + (pos * 16 + 4 * fq) * 2, y1, y2);
                        bf16_t* dp = isq ? dst + (size_t)row * pitch : KG + ((((size_t)((row >> 12) * 2 + wc) * 64 + (srow >> 6)) * 64 + (srow & 63)) * 64);
                        st4(dp + 32 * bj + 4 * fq, y1); st4(dp + 32 * bj + 16 + 4 * fq, y2); } }
        } else if (u.pn == 3) {
            const int hk = wc - 2;
#pragma unroll
            for (int ai = 0; ai < 2; ++ai)
#pragma unroll
                for (int m = 0; m < 4; ++m) { const int row = row0 + ai * HALF + m * 16;
#pragma unroll
                    for (int bj = 0; bj < 2; ++bj)
#pragma unroll
                        for (int n = 0; n < 2; ++n)
#pragma unroll
                            for (int i = 0; i < 4; ++i) VTG[((((size_t)((row >> 12) * 2 + hk) * 64 + ((row & (SEQL - 1)) >> 6)) * 64 + (32 * bj + 16 * n + 4 * fq + i)) * 64) + (row & 63)] = bf1(acc[ai][bj][m][n][i]); }
        } else {
#pragma unroll
            for (int ai = 0; ai < 2; ++ai)
#pragma unroll
                for (int m = 0; m < 4; ++m) { const int row = row0 + ai * HALF + m * 16; float s = 0.f;
#pragma unroll
                    for (int n = 0; n < 2; ++n) { const f32x4 v = acc[ai][0][m][n]; s += dot4(v); st4(ZKV + (size_t)row * 128 + wc * 32 + n * 16 + 4 * fq, v); }
                    s = quad_sum(s); if (fq == 0) SSQKV[row * 4 + wc] = s;
                    if (wc == 0) { const int srow = row & (SEQL - 1), prow = srow >> 6, pcol = srow & 63; const int a = fq >> 1, e0 = 4 * (fq & 1), pos = a ? pcol : prow; f32x4 y1, y2;
                        rope4(acc[ai][1][m][0], acc[ai][1][m][1], ropeM + (pos * 8 + e0) * 2, y1, y2);
                        st4(KPE + (size_t)row * 32 + 16 * a + e0, y1); st4(KPE + (size_t)row * 32 + 16 * a + 8 + e0, y2); } }
        }
    }
};
struct EpiUq {
    static constexpr bool PERM = false, AFTER_DRAIN = false; static constexpr int MIDT = -1;
    bf16_t* QM; const float* SSQQ; const float* ropeM;
    __device__ __forceinline__ void mid(f32x4 (&)[2][2][4][2], const Unit&, int, int) const {}
    __device__ __forceinline__ void operator()(const f32x4 (&acc)[2][2][4][2], const Unit& u, int wr, int wc, int fr, int fq) const {
        asm volatile("" : "+v"(fr), "+v"(fq));
        const int row0 = u.pm * BM + wr * 64 + fr;
#pragma unroll
        for (int ai = 0; ai < 2; ++ai)
#pragma unroll
            for (int m = 0; m < 4; ++m) { const int row = row0 + ai * HALF + m * 16; const f32x4 sq = *(const f32x4*)(SSQQ + row * 4);
                const float sc = C2M / sqrtf(((sq[0] + sq[1]) + (sq[2] + sq[3])) * (1.f / 256.f) + NEPS);
                bf16_t* qrow = QM + (size_t)row * 768;
                if (u.pn < 2) {
#pragma unroll
                    for (int bj = 0; bj < 2; ++bj)
#pragma unroll
                        for (int n = 0; n < 2; ++n) { const int c = u.pn * BM + bj * HALF + wc * 32 + n * 16 + 4 * fq; st4(qrow + (c >> 6) * 96 + (c & 63), acc[ai][bj][m][n] * sc); }
                } else {
                    const int srow = row & (SEQL - 1), prow = srow >> 6, pcol = srow & 63; const int a = fq >> 1, e0 = 4 * (fq & 1), pos = a ? pcol : prow;
#pragma unroll
                    for (int bj = 0; bj < 2; ++bj) { f32x4 y1, y2; rope4(acc[ai][bj][m][0] * sc, acc[ai][bj][m][1] * sc, ropeM + (pos * 8 + e0) * 2, y1, y2);
                        bf16_t* hp = qrow + (4 * bj + wc) * 96 + 64; st4(hp + 16 * a + e0, y1); st4(hp + 16 * a + 8 + e0, y2); }
                } }
    }
};
struct EpiUkv {
    static constexpr bool PERM = false, AFTER_DRAIN = false; static constexpr int MIDT = -1;
    bf16_t *KN, *VTM; const float* SSQKV;
    __device__ __forceinline__ void mid(f32x4 (&)[2][2][4][2], const Unit&, int, int) const {}
    __device__ __forceinline__ void operator()(const f32x4 (&acc)[2][2][4][2], const Unit& u, int wr, int wc, int fr, int fq) const {
        asm volatile("" : "+v"(fr), "+v"(fq));
        const int row0 = u.pm * BM + wr * 64 + fr;
#pragma unroll
        for (int ai = 0; ai < 2; ++ai)
#pragma unroll
            for (int m = 0; m < 4; ++m) { const int row = row0 + ai * HALF + m * 16; const f32x4 sq = *(const f32x4*)(SSQKV + row * 4);
                const float sc = 1.0f / sqrtf(((sq[0] + sq[1]) + (sq[2] + sq[3])) * (1.f / 128.f) + NEPS);
                if (u.pn < 2) {
#pragma unroll
                    for (int bj = 0; bj < 2; ++bj)
#pragma unroll
                        for (int n = 0; n < 2; ++n) { const int c = u.pn * BM + bj * HALF + wc * 32 + n * 16 + 4 * fq; st4(KN + ((((size_t)((row >> 12) * 8 + (c >> 6)) * 64 + ((row & (SEQL - 1)) >> 6)) * 64 + (row & 63)) * 64) + (c & 63), acc[ai][bj][m][n] * sc); }
                } else {
#pragma unroll
                    for (int bj = 0; bj < 2; ++bj)
#pragma unroll
                        for (int n = 0; n < 2; ++n)
#pragma unroll
                            for (int i = 0; i < 4; ++i) { const int c = (u.pn - 2) * BM + bj * HALF + wc * 32 + n * 16 + 4 * fq + i; VTM[((((size_t)((row >> 12) * 8 + (c >> 6)) * 64 + ((row & (SEQL - 1)) >> 6)) * 64 + (c & 63)) * 64) + (row & 63)] = bf1(acc[ai][bj][m][n][i] * sc); }
                } }
    }
};
template <class Epi, class Sched, bool ALIGN_EPI = false, bool SP2 = false>
__device__ __forceinline__ void gemm_phase(PG8_LAS unsigned char* lds, const Gemm g, const Sched S, const Epi E) {
    int tid_ = threadIdx.x; asm volatile("" : "+v"(tid_));
    const int tid = tid_, wid = __builtin_amdgcn_readfirstlane(tid >> 6), lane = tid & 63, wr = wid >> 2, wc = wid & 3, fr = lane & 15, fq = lane >> 4;
    const int K = g.K, nt = K / BK;
    unsigned voffA[2], voffB[2];
#pragma unroll
    for (int i = 0; i < 2; ++i) { int R, C; stage_rc(tid * 16 + i * 8192, R, C); const int Rb = Epi::PERM ? ((R & ~31) + perm32(R & 31)) : R;
        voffA[i] = (unsigned)(R * K + C) * 2u; voffB[i] = (unsigned)(Rb * K + C) * 2u; }
    const size_t kstep = (size_t)(BK * 2);
    const size_t hstep = (size_t)HALF * K * 2;
    const size_t tstep = 2 * hstep;
    const unsigned ldsw = (unsigned)wid * 1024u;
    const int aoff = lds_byte(wr * 64 + fr, fq * 8), boff = lds_byte(wc * 32 + fr, fq * 8);
#define PG8_SA(b, h) (((b) * 2 + (h)) * HTB)
#define PG8_SB(b, h) ((4 + (b) * 2 + (h)) * HTB)
#define PG8_STAGE(bufoff, gbase, voff) do { _Pragma("unroll") for (int _i = 0; _i < 2; ++_i) \
        __builtin_amdgcn_global_load_lds((const unsigned*)((const char*)(gbase) + (voff)[_i]), (PG8_LAS unsigned*)(lds + (bufoff) + ldsw + _i * 8192), 16, 0, 0); } while (0)
#define PG8_LDA(dst, b, h) do { _Pragma("unroll") for (int m = 0; m < 4; ++m) _Pragma("unroll") for (int k = 0; k < 2; ++k) dst[m][k] = *(const PG8_LAS bf16x8*)(lds + PG8_SA(b, h) + aoff + m * 2048 + k * 1024); } while (0)
#define PG8_LDB(dst, b, h) do { _Pragma("unroll") for (int n = 0; n < 2; ++n) _Pragma("unroll") for (int k = 0; k < 2; ++k) dst[n][k] = *(const PG8_LAS bf16x8*)(lds + PG8_SB(b, h) + boff + n * 2048 + k * 1024); } while (0)
#define PG8_MMA(ai, bj, At, Bt) do { __builtin_amdgcn_s_setprio(1); _Pragma("unroll") for (int m = 0; m < 4; ++m) _Pragma("unroll") for (int n = 0; n < 2; ++n) _Pragma("unroll") for (int k = 0; k < 2; ++k) \
        acc[ai][bj][m][n] = __builtin_amdgcn_mfma_f32_16x16x32_bf16(Bt[n][k], At[m][k], acc[ai][bj][m][n], 0, 0, 0); __builtin_amdgcn_s_setprio(0); } while (0)
#define PG8_WAIT_V(n) asm volatile("s_waitcnt vmcnt(" #n ")" ::: "memory")
#define PG8_WAIT_L(n) asm volatile("s_waitcnt lgkmcnt(" #n ")" ::: "memory")
#define PG8_BAR __builtin_amdgcn_s_barrier()
#define PG8_SCHED __builtin_amdgcn_sched_barrier(0)
    Unit cur, nxt; int ui = 0;
    if (!S.next(0, cur)) return;
    f32x4 acc[2][2][4][2];
#pragma unroll
    for (int a = 0; a < 2; ++a)
#pragma unroll
        for (int b = 0; b < 2; ++b)
#pragma unroll
            for (int m = 0; m < 4; ++m)
#pragma unroll
                for (int n = 0; n < 2; ++n) acc[a][b][m][n] = (f32x4){0.f, 0.f, 0.f, 0.f};
    bf16x8 At[4][2], B0[2][2], B1[2][2];
    const char* cA = (const char*)g.A + (size_t)cur.pm * tstep; const char* cB = (const char*)g.Bt + (size_t)cur.pn * tstep;
    S.a_ready(cur);
    if constexpr (SP2) {
        PG8_STAGE(PG8_SB(0, 0), cB, voffB); PG8_STAGE(PG8_SB(0, 1), cB + hstep, voffB); PG8_STAGE(PG8_SA(0, 0), cA, voffA); PG8_STAGE(PG8_SA(0, 1), cA + hstep, voffA);
        if (wr == 1) PG8_BAR;
        PG8_WAIT_V(2); PG8_BAR;
        PG8_STAGE(PG8_SB(1, 0), cB + kstep, voffB); PG8_STAGE(PG8_SA(1, 0), cA + kstep, voffA); PG8_STAGE(PG8_SB(1, 1), cB + hstep + kstep, voffB);
        PG8_WAIT_V(6); PG8_BAR;
    } else {
        PG8_STAGE(PG8_SB(0, 0), cB, voffB); PG8_STAGE(PG8_SA(0, 0), cA, voffA); PG8_STAGE(PG8_SB(0, 1), cB + hstep, voffB); PG8_STAGE(PG8_SA(0, 1), cA + hstep, voffA);
        if (wr == 1) PG8_BAR;
        PG8_WAIT_V(4); PG8_BAR;
        PG8_STAGE(PG8_SB(1, 0), cB + kstep, voffB); PG8_STAGE(PG8_SA(1, 0), cA + kstep, voffA); PG8_STAGE(PG8_SB(1, 1), cB + hstep + kstep, voffB);
        PG8_WAIT_V(6); PG8_BAR;
    }
    for (;;) {
        const bool has_next = S.next(ui + 1, nxt);
        const char* nA = has_next ? (const char*)g.A + (size_t)nxt.pm * tstep : cA; const char* nB = has_next ? (const char*)g.Bt + (size_t)nxt.pn * tstep : cB;
        for (int t = 0; t < nt; t += 2) {
            if constexpr (Epi::MIDT >= 0) { if (t == Epi::MIDT) E.mid(acc, cur, wr, fr); }
            const bool last = (t == nt - 2);
            const char* a1 = cA + (size_t)(t + 1) * kstep;
            const char* a2 = last ? nA : cA + (size_t)(t + 2) * kstep; const char* b2 = last ? nB : cB + (size_t)(t + 2) * kstep;
            const char* a3 = a2 + kstep; const char* b3 = b2 + kstep;
            if (last && has_next) S.a_ready(nxt);
            if constexpr (SP2) {
            PG8_LDB(B0, 0, 0); PG8_LDB(B1, 0, 1); PG8_SCHED; PG8_LDA(At, 0, 0); PG8_STAGE(PG8_SA(1, 1), a1 + hstep, voffA);
            PG8_WAIT_V(8); PG8_WAIT_L(0); PG8_BAR; PG8_MMA(0, 0, At, B0); PG8_MMA(0, 1, At, B1); PG8_BAR; PG8_SCHED;
            PG8_LDA(At, 0, 1); PG8_STAGE(PG8_SB(0, 0), b2, voffB); PG8_STAGE(PG8_SB(0, 1), b2 + hstep, voffB); PG8_STAGE(PG8_SA(0, 0), a2, voffA);
            PG8_WAIT_V(8); PG8_WAIT_L(0); PG8_BAR; PG8_MMA(1, 0, At, B0); PG8_MMA(1, 1, At, B1); PG8_BAR; PG8_SCHED;
            PG8_LDB(B0, 1, 0); PG8_LDB(B1, 1, 1); PG8_SCHED; PG8_LDA(At, 1, 0); PG8_STAGE(PG8_SA(0, 1), a2 + hstep, voffA);
            PG8_WAIT_V(8); PG8_WAIT_L(0); PG8_BAR; PG8_MMA(0, 0, At, B0); PG8_MMA(0, 1, At, B1); PG8_BAR; PG8_SCHED;
            PG8_LDA(At, 1, 1); PG8_STAGE(PG8_SB(1, 0), b3, voffB); PG8_STAGE(PG8_SB(1, 1), b3 + hstep, voffB); PG8_STAGE(PG8_SA(1, 0), a3, voffA);
            PG8_WAIT_V(8); PG8_WAIT_L(0); PG8_BAR; PG8_MMA(1, 0, At, B0); PG8_MMA(1, 1, At, B1); PG8_BAR; PG8_SCHED;
            } else {
            PG8_LDB(B0, 0, 0); PG8_SCHED; PG8_LDA(At, 0, 0); PG8_STAGE(PG8_SA(1, 1), a1 + hstep, voffA);
            PG8_WAIT_L(8); PG8_BAR; PG8_WAIT_L(0); PG8_MMA(0, 0, At, B0); PG8_BAR; PG8_SCHED;
            PG8_LDB(B1, 0, 1); PG8_STAGE(PG8_SB(0, 0), b2, voffB);
            PG8_BAR; PG8_WAIT_L(0); PG8_MMA(0, 1, At, B1); PG8_BAR;
            PG8_LDA(At, 0, 1); PG8_STAGE(PG8_SA(0, 0), a2, voffA);
            PG8_BAR; PG8_WAIT_L(0); PG8_MMA(1, 0, At, B0); PG8_BAR; PG8_SCHED;
            PG8_STAGE(PG8_SB(0, 1), b2 + hstep, voffB);
            PG8_WAIT_V(6); PG8_BAR; PG8_MMA(1, 1, At, B1); PG8_BAR;
            PG8_LDB(B0, 1, 0); PG8_SCHED; PG8_LDA(At, 1, 0); PG8_STAGE(PG8_SA(0, 1), a2 + hstep, voffA);
            PG8_WAIT_L(8); PG8_BAR; PG8_WAIT_L(0); PG8_MMA(0, 0, At, B0); PG8_BAR; PG8_SCHED;
            PG8_LDB(B1, 1, 1); PG8_STAGE(PG8_SB(1, 0), b3, voffB);
            PG8_BAR; PG8_WAIT_L(0); PG8_MMA(0, 1, At, B1); PG8_BAR;
            PG8_LDA(At, 1, 1); PG8_STAGE(PG8_SA(1, 0), a3, voffA);
            PG8_BAR; PG8_WAIT_L(0); PG8_MMA(1, 0, At, B0); PG8_BAR; PG8_SCHED;
            PG8_STAGE(PG8_SB(1, 1), b3 + hstep, voffB);
            PG8_WAIT_V(6); PG8_BAR; PG8_MMA(1, 1, At, B1); PG8_BAR;
            }
        }
        if constexpr (ALIGN_EPI) { if (wr == 0) PG8_BAR; }
        if constexpr (!Epi::AFTER_DRAIN) { E(acc, cur, wr, wc, fr, fq); S.done(cur); }
        if (!has_next) break;
#pragma unroll
        for (int a = 0; a < 2; ++a)
#pragma unroll
            for (int b = 0; b < 2; ++b)
#pragma unroll
                for (int m = 0; m < 4; ++m)
#pragma unroll
                    for (int n = 0; n < 2; ++n) acc[a][b][m][n] = (f32x4){0.f, 0.f, 0.f, 0.f};
        cur = nxt; cA = nA; cB = nB; ++ui;
        if constexpr (ALIGN_EPI) { if (wr == 1) PG8_BAR; }
    }
    PG8_WAIT_V(0);
    if constexpr (!ALIGN_EPI) { if (wr == 0) PG8_BAR; }
    PG8_BAR;
    if constexpr (Epi::AFTER_DRAIN) { E.fused(acc, cur, wr, wc, fr, fq, lds, wid, lane); S.done(cur); }
#undef PG8_SA
#undef PG8_SB
#undef PG8_STAGE
#undef PG8_LDA
#undef PG8_LDB
#undef PG8_MMA
#undef PG8_WAIT_V
#undef PG8_WAIT_L
#undef PG8_BAR
#undef PG8_SCHED
}
}

#define LAS __attribute__((address_space(3)))
namespace att {
typedef unsigned short bf16_t;
typedef short bf16x8 __attribute__((ext_vector_type(8)));
typedef float f32x16 __attribute__((ext_vector_type(16)));
typedef float f32x4 __attribute__((ext_vector_type(4)));
typedef unsigned u32x4 __attribute__((ext_vector_type(4)));
typedef unsigned u32x2 __attribute__((ext_vector_type(2)));
constexpr int KST = 208, VST = 144, KBUF = 64 * KST, VBUF = 64 * VST;
constexpr int MTOK = 32768, SEQL = 4096;
constexpr float THR = 32.0f;
typedef float f32x2_t __attribute__((ext_vector_type(2))); typedef __bf16 bf16x2_t __attribute__((ext_vector_type(2)));
__device__ __forceinline__ unsigned cvtpk(float lo, float hi) { f32x2_t v = {lo, hi}; bf16x2_t b = __builtin_convertvector(v, bf16x2_t); return __builtin_bit_cast(unsigned, b); }
__device__ __forceinline__ float xhalf_max(float m) { auto rr = __builtin_amdgcn_permlane32_swap(__float_as_uint(m), __float_as_uint(m), false, false); return fmaxf(__uint_as_float(rr[0]), __uint_as_float(rr[1])); }
__device__ __forceinline__ float xhalf_sum(float m) { auto rr = __builtin_amdgcn_permlane32_swap(__float_as_uint(m), __float_as_uint(m), false, false); return __uint_as_float(rr[0]) + __uint_as_float(rr[1]); }
__device__ __forceinline__ float max3f(float a, float b, float c) { float r; asm("v_max3_f32 %0, %1, %2, %3" : "=v"(r) : "v"(a), "v"(b), "v"(c)); return r; }
__device__ __forceinline__ float max2f(float a, float b) { float r; asm("v_max_f32_e32 %0, %1, %2" : "=v"(r) : "v"(a), "v"(b)); return r; }
#define ATT_BAR() do { __builtin_amdgcn_sched_barrier(0); asm volatile("s_waitcnt lgkmcnt(0)\n\ts_barrier" ::: "memory"); __builtin_amdgcn_sched_barrier(0); } while (0)

template <int GRP> struct AttCtx {
    LAS unsigned char* lds; const bf16_t* Q; const bf16_t* KN; const bf16_t* KPE; const bf16_t* VT; bf16_t* O;
    const bf16_t *kl, *pl, *vl;
    size_t rowbase, qrow; int b, h0, tid, hi, kro, vro, kwo, pwo, vwo, kkey, kc, pkey, pc; bool trail;
};
template <int GRP> struct AttState {
    static constexpr int NKS = (GRP == 0 ? 96 : 64) / 16;
    bf16x8 qr[NKS]; f32x16 o0, o1; unsigned pw[16]; float mhat, lrun, ssq; int refnz;
};
template <int GRP> __device__ __forceinline__ void att_ldk(const AttCtx<GRP>& C, int step, u32x4& kreg, u32x4& preg) {
    const int h = C.h0 + (step >> 6), t = step & 63, kvh = GRP == 0 ? h : (h >> 2);
    kreg = *(const u32x4*)(C.kl + (kvh * 64 + t) * 4096);
    if (GRP == 0 && C.tid < 256) preg = *(const u32x4*)(C.pl + t * 2048);
}
template <int GRP> __device__ __forceinline__ void att_ldv(const AttCtx<GRP>& C, int step, u32x4& vreg) {
    const int h = C.h0 + (step >> 6), t = step & 63, kvh = GRP == 0 ? h : (h >> 2);
    vreg = *(const u32x4*)(C.vl + (kvh * 64 + t) * 4096);
}
template <int GRP> __device__ __forceinline__ void att_stk(const AttCtx<GRP>& C, int buf, const u32x4& kreg, const u32x4& preg) {
    *(LAS u32x4*)(C.lds + buf * KBUF + C.kwo) = kreg; if (GRP == 0 && C.tid < 256) *(LAS u32x4*)(C.lds + buf * KBUF + C.pwo) = preg;
}
template <int GRP> __device__ __forceinline__ void att_stv(const AttCtx<GRP>& C, int buf, const u32x4& vreg) { *(LAS u32x4*)(C.lds + buf * VBUF + C.vwo) = vreg; }
template <int GRP> __device__ __forceinline__ void att_stld(const AttCtx<GRP>& C, int s, u32x4& kreg, u32x4& preg, u32x4& vreg) {
    constexpr int NSTEP = 256;
    if (s + 2 < NSTEP) att_stk<GRP>(C, s & 1, kreg, preg);
    if (s + 1 < NSTEP) att_stv<GRP>(C, (s + 1) & 1, vreg);
    if (s + 3 < NSTEP) att_ldk<GRP>(C, s + 3, kreg, preg);
    if (s + 2 < NSTEP) att_ldv<GRP>(C, s + 2, vreg);
}
template <int GRP, int KS0, int N> __device__ __forceinline__ void att_kfrag(const AttCtx<GRP>& C, int slot, bf16x8 (&kf)[2 * N]) {
    const LAS unsigned char* kb = C.lds + slot * KBUF + C.kro;
#pragma unroll
    for (int i = 0; i < N; ++i) { kf[2 * i] = *(const LAS bf16x8*)(kb + (KS0 + i) * 32); kf[2 * i + 1] = *(const LAS bf16x8*)(kb + 32 * KST + (KS0 + i) * 32); }
}
template <int GRP> __device__ __forceinline__ void att_vfrag(const AttCtx<GRP>& C, int buf, bf16x8 (&vf)[8]) {
    const LAS unsigned char* vb = C.lds + buf * VBUF + C.vro;
#pragma unroll
    for (int ks = 0; ks < 4; ++ks) { vf[2 * ks] = *(const LAS bf16x8*)(vb + ks * 32); vf[2 * ks + 1] = *(const LAS bf16x8*)(vb + 32 * VST + ks * 32); }
}
template <int GRP> __device__ __forceinline__ void att_pv(AttState<GRP>& S, const bf16x8 (&vf)[8]) {
#pragma unroll
    for (int ks = 0; ks < 4; ++ks) { const u32x4 w = {S.pw[4 * ks], S.pw[4 * ks + 1], S.pw[4 * ks + 2], S.pw[4 * ks + 3]}; const bf16x8 pb = __builtin_bit_cast(bf16x8, w);
        S.o0 = __builtin_amdgcn_mfma_f32_32x32x16_bf16(vf[2 * ks], pb, S.o0, 0, 0, 0); S.o1 = __builtin_amdgcn_mfma_f32_32x32x16_bf16(vf[2 * ks + 1], pb, S.o1, 0, 0, 0); }
}
template <int GRP> __device__ __forceinline__ void att_finish_head(const AttCtx<GRP>& C, AttState<GRP>& S, int h) {
    const float inv = 1.0f / xhalf_sum(S.lrun);
    bf16_t* orow = C.O + C.qrow * 1024 + GRP * 512 + h * 64 + 4 * C.hi;
#pragma unroll
    for (int rr = 0; rr < 4; ++rr) {
        const f32x4 v0 = (f32x4){S.o0[4 * rr], S.o0[4 * rr + 1], S.o0[4 * rr + 2], S.o0[4 * rr + 3]} * inv, v1 = (f32x4){S.o1[4 * rr], S.o1[4 * rr + 1], S.o1[4 * rr + 2], S.o1[4 * rr + 3]} * inv;
        S.ssq += (v0[0] * v0[0] + v0[1] * v0[1]) + (v0[2] * v0[2] + v0[3] * v0[3]) + (v1[0] * v1[0] + v1[1] * v1[1]) + (v1[2] * v1[2] + v1[3] * v1[3]);
        u32x2 s0, s1; s0.x = cvtpk(v0[0], v0[1]); s0.y = cvtpk(v0[2], v0[3]); s1.x = cvtpk(v1[0], v1[1]); s1.y = cvtpk(v1[2], v1[3]);
        *(u32x2*)(orow + 8 * rr) = s0; *(u32x2*)(orow + 32 + 8 * rr) = s1;
    }
}
template <int GRP, bool has_next> __device__ __forceinline__ void att_step(const AttCtx<GRP>& C, AttState<GRP>& S, int s, f32x16& P0, f32x16& P1, f32x16& PN0, f32x16& PN1, u32x4& kreg, u32x4& preg, u32x4& vreg) {
    constexpr int DK = GRP == 0 ? 96 : 64, NKS = DK / 16, QP = GRP == 0 ? 768 : 512, NSTEP = 256, NK0 = NKS / 2, NK1 = NKS - NK0;
    const int h = C.h0 + (s >> 6), t = s & 63;
    bf16x8 kfa[2 * NK0], kfb[2 * NK1], vf[8];
    if (has_next) {
        if (t == 63) {
#pragma unroll
            for (int ks = 0; ks < NKS; ++ks) S.qr[ks] = *(const bf16x8*)(C.Q + C.qrow * QP + (h + 1) * DK + ks * 16 + C.hi * 8);
        }
        att_kfrag<GRP, 0, NK0>(C, (s + 1) & 1, kfa);
    }
    if (has_next) { PN0 = __builtin_amdgcn_mfma_f32_32x32x16_bf16(kfa[0], S.qr[0], (f32x16){}, 0, 0, 0); PN1 = __builtin_amdgcn_mfma_f32_32x32x16_bf16(kfa[1], S.qr[0], (f32x16){}, 0, 0, 0); }
    if ((t & 7) == 0) {
        float ma = max3f(P0[0], P0[1], P0[2]), mb = max3f(P0[3], P0[4], P0[5]), mc = max3f(P1[0], P1[1], P1[2]), md = max3f(P1[3], P1[4], P1[5]);
        ma = max3f(ma, P0[6], P0[7]); mb = max3f(mb, P0[8], P0[9]); mc = max3f(mc, P1[6], P1[7]); md = max3f(md, P1[8], P1[9]);
        ma = max3f(ma, P0[10], P0[11]); mb = max3f(mb, P0[12], P0[13]); mc = max3f(mc, P1[10], P1[11]); md = max3f(md, P1[12], P1[13]);
        ma = max3f(ma, P0[14], P0[15]); mc = max3f(mc, P1[14], P1[15]); ma = max3f(ma, mb, mc); mb = md;
        const float mx = xhalf_max(max2f(ma, mb));
        const int up = __any(mx > THR), dn = (t == 0) ? __any(mx < -THR) : 0;
        if (up | dn) {
            const float dl = ceilf((t == 0) ? mx : fmaxf(mx, 0.f));
            const float f = (t == 0) ? 0.f : __builtin_amdgcn_exp2f(-dl);
            S.mhat += dl; S.lrun *= f;
#pragma unroll
            for (int r = 0; r < 16; ++r) { P0[r] -= dl; P1[r] -= dl; S.o0[r] *= f; S.o1[r] *= f; }
            S.refnz = __any(S.mhat != 0.f);
        }
    }
    __builtin_amdgcn_sched_barrier(0);
    const unsigned mbits = (t == 63 || C.hi != 0) ? 0u : (__float_as_uint(-S.mhat) >> 16);
    const u32x4 qxw = {mbits, 0u, 0u, 0u}; const bf16x8 qx = __builtin_bit_cast(bf16x8, qxw);
    const bf16x8 ones = {0x3f80, 0x3f80, 0x3f80, 0x3f80, 0x3f80, 0x3f80, 0x3f80, 0x3f80};
    constexpr int NE = NKS - 1;
    float ra = 0.f, rb = 0.f, rc = 0.f, rd = 0.f;
#define ATT_SUMPACK(j) do { const float e0_ = (j) < 8 ? P0[2 * ((j) & 7)] : P1[2 * ((j) & 7)], e1_ = (j) < 8 ? P0[2 * ((j) & 7) + 1] : P1[2 * ((j) & 7) + 1]; \
        if ((j) & 1) { rc += e0_; rd += e1_; } else { ra += e0_; rb += e1_; } S.pw[j] = cvtpk(e0_, e1_); } while (0)
#pragma unroll
    for (int c = 1; c < NKS; ++c) {
        if (has_next) {
            if (c == NK0) att_kfrag<GRP, NK0, NK1>(C, (s + 1) & 1, kfb);
            const bf16x8 a0 = c < NK0 ? kfa[2 * c] : kfb[2 * (c - NK0)], a1 = c < NK0 ? kfa[2 * c + 1] : kfb[2 * (c - NK0) + 1];
            PN0 = __builtin_amdgcn_mfma_f32_32x32x16_bf16(a0, S.qr[c], PN0, 0, 0, 0); PN1 = __builtin_amdgcn_mfma_f32_32x32x16_bf16(a1, S.qr[c], PN1, 0, 0, 0);
        }
#pragma unroll
        for (int j = (c - 1) * 16 / NE; j < c * 16 / NE; ++j) {
            if (j < 8) { P0[2 * j] = __builtin_amdgcn_exp2f(P0[2 * j]); P0[2 * j + 1] = __builtin_amdgcn_exp2f(P0[2 * j + 1]); }
            else { P1[2 * (j - 8)] = __builtin_amdgcn_exp2f(P1[2 * (j - 8)]); P1[2 * (j - 8) + 1] = __builtin_amdgcn_exp2f(P1[2 * (j - 8) + 1]); }
        }
        if (c > 1) {
#pragma unroll
            for (int j = (c - 2) * 16 / NE; j < (c - 1) * 16 / NE; ++j) ATT_SUMPACK(j);
        }
        __builtin_amdgcn_sched_barrier(0);
    }
    if (has_next && S.refnz && t != 63) { PN0 = __builtin_amdgcn_mfma_f32_32x32x16_bf16(ones, qx, PN0, 0, 0, 0); PN1 = __builtin_amdgcn_mfma_f32_32x32x16_bf16(ones, qx, PN1, 0, 0, 0); }
    att_vfrag<GRP>(C, s & 1, vf);
#pragma unroll
    for (int j = (NE - 1) * 16 / NE; j < 16; ++j) ATT_SUMPACK(j);
#undef ATT_SUMPACK
    S.lrun += (ra + rb) + (rc + rd);
    att_pv<GRP>(S, vf);
    if (t == 63) {
        att_finish_head<GRP>(C, S, h);
        S.o0 = (f32x16){}; S.o1 = (f32x16){}; S.lrun = 0.f; S.mhat = 0.f; S.refnz = 0;
    }
    att_stld<GRP>(C, s, kreg, preg, vreg);
    ATT_BAR();
}
template <int GRP>
__device__ __forceinline__ void attn_unit(LAS unsigned char* lds, int b, int qb, int hh, const bf16_t* __restrict__ Q, const bf16_t* __restrict__ KN, const bf16_t* __restrict__ KPE,
                                          const bf16_t* __restrict__ VT, bf16_t* __restrict__ O, float* __restrict__ RS) {
    constexpr int DK = GRP == 0 ? 96 : 64, NKS = DK / 16, QP = GRP == 0 ? 768 : 512, NSTEP = 4 * 64;
    int tid_ = threadIdx.x; asm volatile("" : "+v"(tid_));
    const int tid = tid_, lane = tid & 63, r32 = lane & 31, hi = lane >> 5, wid = __builtin_amdgcn_readfirstlane(tid >> 6);
    AttCtx<GRP> C;
    C.b = b; C.h0 = 4 * hh; C.lds = lds; C.Q = Q; C.KN = KN; C.KPE = KPE; C.VT = VT; C.O = O; C.tid = tid; C.hi = hi; C.trail = false;
    C.rowbase = (size_t)b * SEQL; C.qrow = C.rowbase + (size_t)qb * 256 + wid * 32 + r32;
    const int pr = (r32 & 19) | ((r32 & 4) << 1) | ((r32 & 8) >> 1);
    C.kro = pr * KST + hi * 16; C.vro = 2 * KBUF + r32 * VST + hi * 16;
    C.kkey = tid >> 3; C.kc = tid & 7; C.pkey = (tid >> 2) & 63; C.pc = tid & 3;
    { constexpr int NHK = GRP == 0 ? 8 : 2; const size_t lo = (size_t)C.kkey * 64 + C.kc * 8;
      C.kl = KN + (size_t)(b * NHK) * 64 * 4096 + lo; C.vl = VT + (size_t)(b * NHK) * 64 * 4096 + lo; C.pl = KPE + (C.rowbase + C.pkey) * 32 + C.pc * 8; }
    C.kwo = C.kkey * KST + C.kc * 16; C.pwo = C.pkey * KST + 128 + C.pc * 16; C.vwo = 2 * KBUF + C.kkey * VST + C.kc * 16;
    u32x4 kA, pA = {0u, 0u, 0u, 0u}, vA;
    AttState<GRP> S;
    S.o0 = (f32x16){}; S.o1 = (f32x16){}; S.mhat = 0.f; S.lrun = 0.f; S.ssq = 0.f; S.refnz = 0;
#pragma unroll
    for (int i = 0; i < 16; ++i) S.pw[i] = 0u;
    { u32x4 kB, pB = {0u, 0u, 0u, 0u};
      att_ldk<GRP>(C, 0, kA, pA); att_ldk<GRP>(C, 1, kB, pB); att_ldv<GRP>(C, 0, vA);
      att_stk<GRP>(C, 0, kA, pA); att_stk<GRP>(C, 1, kB, pB); att_stv<GRP>(C, 0, vA); }
    att_ldk<GRP>(C, 2, kA, pA); att_ldv<GRP>(C, 1, vA);
#pragma unroll
    for (int ks = 0; ks < NKS; ++ks) S.qr[ks] = *(const bf16x8*)(Q + C.qrow * QP + C.h0 * DK + ks * 16 + hi * 8);
    ATT_BAR();
    f32x16 pa0 = {}, pa1 = {}, pb0 = {}, pb1 = {};
    {
        bf16x8 kf[2 * NKS]; att_kfrag<GRP, 0, NKS>(C, 0, kf);
#pragma unroll
        for (int ks = 0; ks < NKS; ++ks) { pa0 = __builtin_amdgcn_mfma_f32_32x32x16_bf16(kf[2 * ks], S.qr[ks], pa0, 0, 0, 0); pa1 = __builtin_amdgcn_mfma_f32_32x32x16_bf16(kf[2 * ks + 1], S.qr[ks], pa1, 0, 0, 0); }
    }
    if (wid >= 4) __builtin_amdgcn_s_setprio(1);
    asm volatile("s_nop 15\n\ts_nop 7" : "+v"(pa0), "+v"(pa1));
    for (int s = 0; s < NSTEP - 2; s += 2) { att_step<GRP, true>(C, S, s, pa0, pa1, pb0, pb1, kA, pA, vA); att_step<GRP, true>(C, S, s + 1, pb0, pb1, pa0, pa1, kA, pA, vA); }
    att_step<GRP, true>(C, S, NSTEP - 2, pa0, pa1, pb0, pb1, kA, pA, vA); att_step<GRP, false>(C, S, NSTEP - 1, pb0, pb1, pa0, pa1, kA, pA, vA);
    __builtin_amdgcn_s_setprio(0);
    const float ssq = xhalf_sum(S.ssq);
    if (hi == 0) RS[C.qrow * 4 + GRP * 2 + hh] = ssq;
    __syncthreads();
}
}

typedef unsigned short bf16;
typedef float f32x4 __attribute__((ext_vector_type(4)));
typedef unsigned v4u __attribute__((ext_vector_type(4)));
typedef unsigned v2u __attribute__((ext_vector_type(2)));
constexpr int M = 32768, SEQ = 4096, D = 1024, DFF = 2816, DIN = 1184, NMOD9 = 9216;
constexpr size_t MiB = 1u << 20;
constexpr size_t WS_MOD = 0, MOD_ZERO_BYTES = 512 * 1024;
constexpr size_t WS_ROPEM = 1 * MiB, WS_ROPEG = 1 * MiB + 65536;
constexpr size_t WS_WGU1 = 2 * MiB, WS_WD1 = 14 * MiB, WS_WGU2 = 20 * MiB, WS_WD2 = 32 * MiB, WS_WIN = 38 * MiB, WS_WUQ = 41 * MiB, WS_WUKV = 42 * MiB, WS_WOUT = 43 * MiB;
constexpr size_t WS_SSQQ = 46 * MiB, WS_SSQKV = 47 * MiB, WS_RSO = 48 * MiB, WS_KPE = 50 * MiB;
constexpr size_t WS_H = 64 * MiB, WS_ACT = 128 * MiB, WS_XR = 304 * MiB;
constexpr size_t WS_QM = 128 * MiB, WS_KN = 176 * MiB, WS_VTM = 208 * MiB, WS_O = 240 * MiB;
constexpr size_t WS_ZQ = 432 * MiB, WS_ZKV = 448 * MiB, WS_QG = 456 * MiB, WS_KG = 488 * MiB, WS_VTG = 496 * MiB, WS_END = 504 * MiB;
constexpr int LDS_BYTES = 131072 + 64, LDS_BARST = 131072;
constexpr size_t WS_BAR = 384 * 1024;

__device__ __forceinline__ unsigned f2bf(float f) { unsigned u = __builtin_bit_cast(unsigned, f); return (u + 0x7fffu + ((u >> 16) & 1u)) >> 16; }
__device__ __forceinline__ unsigned pk2(float lo, float hi) { return f2bf(lo) | (f2bf(hi) << 16); }
#define LDS_WAIT() asm volatile("s_waitcnt lgkmcnt(0)" ::: "memory")
__device__ __forceinline__ float wave_sum(float v) {
#pragma unroll
    for (int o = 1; o < 64; o <<= 1) v += __shfl_xor(v, o);
    return v;
}
struct RmId { __device__ __forceinline__ int operator()(int n) const { return n; } __device__ __forceinline__ float scale(int) const { return 1.0f; } };
struct RmGu { __device__ __forceinline__ int operator()(int n) const { const int up = n >= DFF, j = up ? n - DFF : n; return 256 * (j >> 7) + 128 * up + (j & 127); }
              __device__ __forceinline__ float scale(int n) const { return n >= DFF ? 0.6931471805599453f : 1.4426950408889634f; } };
struct RmWin { __device__ __forceinline__ int operator()(int c) const {
    if (c < 256) return c;
    if (c < 384) return 1024 + (c - 256);
    if (c < 416) { const int d = c - 384, a = d >> 4, p = (d >> 3) & 1, e = d & 7; return 1024 + 128 + 16 * p + 8 * a + e; }
    if (c < 928) { const int h = (c - 416) >> 6, d = (c - 416) & 63; return 256 * (1 + (h >> 2)) + 128 * (d >> 5) + 32 * (h & 3) + (d & 31); }
    if (c < 1056) { const int hk = (c - 928) >> 6, d = (c - 928) & 63; return 768 + 128 * (d >> 5) + 32 * hk + (d & 31); }
    { const int hk = (c - 1056) >> 6, e = (c - 1056) & 63; return 768 + 128 * (e >> 5) + 32 * (2 + hk) + (e & 31); } }  __device__ __forceinline__ float scale(int) const { return 1.0f; } };
struct RmUq { __device__ __forceinline__ int operator()(int c) const { const int h = c / 96, j = c % 96; if (j < 64) return h * 64 + j; const int d = j - 64, a = d >> 4, p = (d >> 3) & 1, e = d & 7; return 512 + 32 * h + 16 * p + 8 * a + e; }  __device__ __forceinline__ float scale(int) const { return 1.0f; } };
struct RmUkv { __device__ __forceinline__ int operator()(int c) const { const int h = c >> 7, j = c & 127; return j < 64 ? h * 64 + j : 512 + h * 64 + (j - 64); }  __device__ __forceinline__ float scale(int) const { return 1.0f; } };

template <class RM> __device__ __forceinline__ void tr_item(const float* __restrict__ W, int K, int N, bf16* __restrict__ WT, RM rm, const float* ks0, const float* ks1, int ksplit, LAS float* scr, int item, int lane) {
    const int nblk = N / 32, kb = item / nblk, nb = item % nblk, k0 = 64 * kb, n0 = 32 * nb;
    f32x4 wv[8];
    const int r8 = lane >> 3, cg = lane & 7;
#pragma unroll
    for (int i = 0; i < 8; ++i) wv[i] = *(const f32x4*)(W + (size_t)(k0 + 8 * i + r8) * N + n0 + 4 * cg);
    const f32x4 cs = {rm.scale(n0 + 4 * cg), rm.scale(n0 + 4 * cg + 1), rm.scale(n0 + 4 * cg + 2), rm.scale(n0 + 4 * cg + 3)};
#pragma unroll
    for (int i = 0; i < 8; ++i) { const int kk = 8 * i + r8; f32x4 w = wv[i] * cs;
        if (ks0) { const int k = k0 + kk; w = w * ((k < ksplit) ? ks0[k] : ks1[k - ksplit]); }
        scr[kk * 33 + 4 * cg] = w[0]; scr[kk * 33 + 4 * cg + 1] = w[1]; scr[kk * 33 + 4 * cg + 2] = w[2]; scr[kk * 33 + 4 * cg + 3] = w[3]; }
    LDS_WAIT(); asm volatile("" ::: "memory");
    const int c = lane & 7;
#pragma unroll
    for (int j = 0; j < 4; ++j) { const int n = (lane >> 3) + 8 * j; const LAS float* s = scr + (8 * c) * 33 + n;
        v4u o; o.x = pk2(s[0 * 33], s[1 * 33]); o.y = pk2(s[2 * 33], s[3 * 33]); o.z = pk2(s[4 * 33], s[5 * 33]); o.w = pk2(s[6 * 33], s[7 * 33]);
        *(v4u*)(WT + (size_t)rm(n0 + n) * K + k0 + 8 * c) = o; }
    LDS_WAIT(); asm volatile("" ::: "memory");
}
__device__ __forceinline__ void mod_item(const float* __restrict__ c, const float* __restrict__ wada, const float* __restrict__ bada, float* MOD, LAS float* scr, int item, int lane) {
    const int cgp = item % 144, kc = item / 144, n = cgp * 64 + lane, k0 = kc * 128;
#pragma unroll
    for (int i = 0; i < 16; ++i) { const int idx = i * 64 + lane, b = idx >> 7, kk = idx & 127; const float v = c[b * D + k0 + kk]; scr[idx] = v / (1.0f + expf(-v)); }
    LDS_WAIT(); asm volatile("" ::: "memory");
    float acc[8];
#pragma unroll
    for (int b = 0; b < 8; ++b) acc[b] = 0.f;
    for (int kq = 0; kq < 128; kq += 32) {
        float wv[32];
#pragma unroll
        for (int i = 0; i < 32; ++i) wv[i] = wada[(size_t)(k0 + kq + i) * NMOD9 + n];
#pragma unroll
        for (int i = 0; i < 32; ++i)
#pragma unroll
            for (int b = 0; b < 8; ++b) acc[b] += scr[b * 128 + kq + i] * wv[i];
    }
    if (kc == 0) { const float bb = bada[n];
#pragma unroll
        for (int b = 0; b < 8; ++b) acc[b] += bb; }
#pragma unroll
    for (int b = 0; b < 8; ++b) atomicAdd(MOD + b * NMOD9 + n, acc[b]);
    LDS_WAIT(); asm volatile("" ::: "memory");
}
template <int MODE, bool XB> __device__ __forceinline__ void norm_pass(const void* __restrict__ X, const float* __restrict__ g, const float* __restrict__ shift, const float* __restrict__ scale,
                                                             bf16* __restrict__ Hb, float* __restrict__ Of, int gw, int NGW, int lane) {
    asm volatile("" : "+v"(lane));
    for (int m0 = gw * 16; m0 < M; m0 += NGW * 16) {
        const int b = m0 / SEQ;
        f32x4 gm[4], sh[4];
#pragma unroll
        for (int j = 0; j < 4; ++j) { const int col = 4 * lane + 256 * j; gm[j] = *(const f32x4*)(g + col);
            if (MODE == 0) { gm[j] = gm[j] * (*(const f32x4*)(scale + (size_t)b * NMOD9 + col) + 1.0f); sh[j] = *(const f32x4*)(shift + (size_t)b * NMOD9 + col); } }
        for (int r = 0; r < 16; ++r) {
            f32x4 v[4]; float s = 0.f;
#pragma unroll
            for (int j = 0; j < 4; ++j) {
                if constexpr (XB) { const v2u w = *(const v2u*)((const bf16*)X + (size_t)(m0 + r) * D + 4 * lane + 256 * j);
                    v[j] = (f32x4){__uint_as_float(w.x << 16), __uint_as_float(w.x & 0xffff0000u), __uint_as_float(w.y << 16), __uint_as_float(w.y & 0xffff0000u)}; }
                else v[j] = *(const f32x4*)((const float*)X + (size_t)(m0 + r) * D + 4 * lane + 256 * j);
                s += (v[j][0] * v[j][0] + v[j][1] * v[j][1]) + (v[j][2] * v[j][2] + v[j][3] * v[j][3]); }
            const float rstd = 1.0f / sqrtf(wave_sum(s) * (1.f / D) + 1e-6f);
#pragma unroll
            for (int j = 0; j < 4; ++j) {
                if (MODE == 0) { const f32x4 o = v[j] * rstd * gm[j] + sh[j]; v2u w; w.x = pk2(o[0], o[1]); w.y = pk2(o[2], o[3]); *(v2u*)(Hb + (size_t)(m0 + r) * D + 4 * lane + 256 * j) = w; }
                else { *(f32x4*)(Of + (size_t)(m0 + r) * D + 4 * lane + 256 * j) = v[j] * rstd * gm[j]; }
            }
        }
    }
}

#define XB_TMO      128
#define XB_XCNT(j)  (256  + 64 * (j))
#define XB_XSUB(j)  (1280 + 64 * (j))
#define XB_XGEN(j)  (2304 + 64 * (j))
#define XB_TOP      3328
#define XB_TOPGEN   3392
#define XCD_BAR_WORDS 3456
#define XB_SPIN_CAP (1u << 24)

__device__ __forceinline__ unsigned xb_ld(unsigned* p)              { return __hip_atomic_load(p, __ATOMIC_RELAXED, __HIP_MEMORY_SCOPE_AGENT); }
__device__ __forceinline__ unsigned xb_add(unsigned* p, unsigned v) { return __hip_atomic_fetch_add(p, v, __ATOMIC_RELAXED, __HIP_MEMORY_SCOPE_AGENT); }
__device__ __forceinline__ unsigned xb_xcc_id() { return (unsigned)__builtin_amdgcn_s_getreg((3 << 11) | 20) & 0xFu; }
#define XB_SPIN(cond, bar) do { unsigned _sp = 0; while (cond) { __builtin_amdgcn_s_sleep(1); \
    if ((++_sp & 255u) == 0u) { if (xb_ld(&(bar)[XB_TMO])) break; if (_sp > XB_SPIN_CAP) { atomicAdd(&(bar)[XB_TMO], 1u); break; } } } } while (0)
struct XcdBarrier {
    unsigned* bar; unsigned x;
    volatile LAS unsigned* st;
};

__device__ __forceinline__ XcdBarrier xcd_barrier_post(unsigned* bar, volatile LAS unsigned* st) {
    XcdBarrier b; b.bar = bar; b.x = xb_xcc_id(); b.st = st;
    if (threadIdx.x == 0) (void)xb_add(&bar[XB_XCNT(b.x)], 1u);
    return b;
}
__device__ __forceinline__ void xcd_barrier_complete(unsigned* bar, unsigned x, unsigned& nloc, unsigned& nx) {
    const unsigned G = gridDim.x * gridDim.y * gridDim.z;
    unsigned sum, cnt, mine, sp = 0u;
    for (;;) {
        sum = 0u; cnt = 0u; mine = 0u;
#pragma unroll
        for (unsigned j = 0; j < 16; ++j) { const unsigned c = xb_ld(&bar[XB_XCNT(j)]); sum += c; cnt += (c > 0u) ? 1u : 0u; mine = (j == x) ? c : mine; }
        if (sum == G) break;
        __builtin_amdgcn_s_sleep(1);
        if ((++sp & 255u) == 0u) { if (xb_ld(&bar[XB_TMO])) break; if (sp > XB_SPIN_CAP) { atomicAdd(&bar[XB_TMO], 1u); break; } }
    }
    nloc = mine > 0u ? mine : 1u; nx = cnt > 0u ? cnt : 1u;
}

__device__ __forceinline__ void xcd_barrier(const XcdBarrier& b) {
    asm volatile("s_waitcnt vmcnt(0)" ::: "memory");
    __syncthreads();
    if (threadIdx.x == 0) {
        unsigned* bar = b.bar;
        __builtin_amdgcn_s_waitcnt(0);
        unsigned nloc = b.st[0], nx = b.st[1];
        if (nloc == 0u) { xcd_barrier_complete(bar, b.x, nloc, nx); b.st[0] = nloc; b.st[1] = nx; }
        const unsigned old = xb_add(&bar[XB_XSUB(b.x)], 1u);
        const unsigned gen = old / nloc;
        if (old + 1u == (gen + 1u) * nloc) {
            __builtin_amdgcn_fence(__ATOMIC_RELEASE, "agent");
            asm volatile("s_waitcnt vmcnt(0)" ::: "memory");
            const unsigned og = xb_add(&bar[XB_TOP], 1u);
            const unsigned tg = og / nx;
            if (og + 1u == (tg + 1u) * nx) xb_add(&bar[XB_TOPGEN], 1u);
            else XB_SPIN(xb_ld(&bar[XB_TOPGEN]) == tg, bar);
            __builtin_amdgcn_fence(__ATOMIC_ACQUIRE, "agent");
            xb_add(&bar[XB_XGEN(b.x)], 1u);
            asm volatile("s_waitcnt vmcnt(0)" ::: "memory");
        } else {
            XB_SPIN(xb_ld(&bar[XB_XGEN(b.x)]) == gen, bar);
            __builtin_amdgcn_fence(__ATOMIC_ACQUIRE, "agent");
            asm volatile("s_waitcnt vmcnt(0)" ::: "memory");
        }
    }
    __syncthreads();
}


#ifndef ONLY_PHASE
#define ONLY_PHASE -1
#endif
#define PHON(k) (ONLY_PHASE < 0 || ONLY_PHASE == (k))
struct Args { const float* in[22]; float* out; unsigned char* ws; };
__global__ void __launch_bounds__(512) fwd_megakernel(Args a) {
    extern __shared__ __attribute__((aligned(16))) unsigned char lds_raw[];
    LAS unsigned char* lds = (LAS unsigned char*)lds_raw;
    cg::grid_group grid = cg::this_grid();
    const int tid = threadIdx.x, lane = tid & 63, wave = __builtin_amdgcn_readfirstlane(tid >> 6);
    const int G = gridDim.x, bx = blockIdx.x, gw = bx * 8 + wave, NGW = G * 8;
    unsigned char* ws = a.ws;
    float* MOD = (float*)(ws + WS_MOD); float* ROPEM = (float*)(ws + WS_ROPEM); float* ROPEG = (float*)(ws + WS_ROPEG);
    bf16 *WGU1 = (bf16*)(ws + WS_WGU1), *WD1 = (bf16*)(ws + WS_WD1), *WGU2 = (bf16*)(ws + WS_WGU2), *WD2 = (bf16*)(ws + WS_WD2), *WIN = (bf16*)(ws + WS_WIN), *WUQ = (bf16*)(ws + WS_WUQ), *WUKV = (bf16*)(ws + WS_WUKV), *WOUT = (bf16*)(ws + WS_WOUT);
    float *SSQQ = (float*)(ws + WS_SSQQ), *SSQKV = (float*)(ws + WS_SSQKV), *RSO = (float*)(ws + WS_RSO), *XRf_unused = nullptr; bf16* XR = (bf16*)(ws + WS_XR);
    bf16 *KPE = (bf16*)(ws + WS_KPE), *H = (bf16*)(ws + WS_H), *ACT = (bf16*)(ws + WS_ACT), *QM = (bf16*)(ws + WS_QM), *KN = (bf16*)(ws + WS_KN), *VTM = (bf16*)(ws + WS_VTM), *OB = (bf16*)(ws + WS_O);
    bf16 *ZQ = (bf16*)(ws + WS_ZQ), *ZKV = (bf16*)(ws + WS_ZKV), *QG = (bf16*)(ws + WS_QG), *KG = (bf16*)(ws + WS_KG), *VTG = (bf16*)(ws + WS_VTG);
    const float* x = a.in[0];
    if (tid < 16) ((LAS unsigned*)(lds + LDS_BARST))[tid] = 0u;
    __syncthreads();
    const XcdBarrier bar = xcd_barrier_post((unsigned*)(ws + WS_BAR), (volatile LAS unsigned*)(lds + LDS_BARST));

    if constexpr (PHON(0)) {
        LAS float* scr = (LAS float*)(lds + wave * 16384);
        for (int it = gw; it < 1152; it += NGW) mod_item(a.in[1], a.in[2], a.in[3], MOD, scr, it, lane);
        for (int i = bx * 512 + tid; i < 96 * 1024 / 8; i += G * 512) *(v4u*)(WIN + (size_t)1184 * D + (size_t)i * 8) = (v4u){0u, 0u, 0u, 0u};
        for (int i = bx * 512 + tid; i < 64 * 8 + 64 * 16; i += G * 512) {
            if (i < 512) { const int pos = i >> 3, e = i & 7; const float inv = powf(10000.0f, -((float)e * 2.0f / 16.0f)), ang = (float)pos * inv; ROPEM[2 * i] = cosf(ang); ROPEM[2 * i + 1] = sinf(ang); }
            else { const int k = i - 512, pos = k >> 4, f = k & 15; const float inv = powf(10000.0f, -((float)f * 2.0f / 32.0f)), ang = (float)pos * inv; ROPEG[2 * k] = cosf(ang); ROPEG[2 * k + 1] = sinf(ang); }
        }
    }
    grid.sync();
    if constexpr (PHON(1)) norm_pass<0, false>(x, a.in[4], MOD + 0 * D, MOD + 1 * D, H, nullptr, gw, NGW, lane);
    if constexpr (PHON(0)) {
        LAS float* scr = (LAS float*)(lds + wave * 16384);
        constexpr int I_GU = 16 * 176, I_DN = 44 * 32, I_IN = 16 * 37, I_UQ = 4 * 24, I_UKV = 2 * 32, I_OUT = 16 * 32;
        constexpr int NITEMS = 2 * (I_GU + I_DN) + I_IN + I_UQ + I_UKV + I_OUT;
        for (int it = gw; it < NITEMS; it += NGW) {
            int r = it;
            if (r < I_GU) { tr_item(a.in[5], D, 2 * DFF, WGU1, RmGu{}, nullptr, nullptr, 0, scr, r, lane); continue; } r -= I_GU;
            if (r < I_DN) { tr_item(a.in[6], DFF, D, WD1, RmId{}, nullptr, nullptr, 0, scr, r, lane); continue; } r -= I_DN;
            if (r < I_GU) { tr_item(a.in[19], D, 2 * DFF, WGU2, RmGu{}, nullptr, nullptr, 0, scr, r, lane); continue; } r -= I_GU;
            if (r < I_DN) { tr_item(a.in[20], DFF, D, WD2, RmId{}, nullptr, nullptr, 0, scr, r, lane); continue; } r -= I_DN;
            if (r < I_IN) { tr_item(a.in[8], D, DIN, WIN, RmWin{}, nullptr, nullptr, 0, scr, r, lane); continue; } r -= I_IN;
            if (r < I_UQ) { tr_item(a.in[10], 256, 768, WUQ, RmUq{}, a.in[9], a.in[9], 256, scr, r, lane); continue; } r -= I_UQ;
            if (r < I_UKV) { tr_item(a.in[12], 128, 1024, WUKV, RmUkv{}, a.in[11], a.in[11], 128, scr, r, lane); continue; } r -= I_UKV;
            tr_item(a.in[17], D, D, WOUT, RmId{}, a.in[15], a.in[16], 512, scr, r, lane);
        }
    }
    xcd_barrier(bar);
    if constexpr (PHON(2)) { pg8::Gemm g{H, WGU1, M, 2 * DFF, D}; pg8::StaticOrder S; S.init(M, 2 * DFF, G, bx); pg8::EpiSwiglu E{ACT}; pg8::gemm_phase<pg8::EpiSwiglu, pg8::StaticOrder, true, true>(lds, g, S, E); }
    xcd_barrier(bar);
    if constexpr (PHON(3)) { pg8::Gemm g{ACT, WD1, M, D, DFF}; pg8::StaticOrder S; S.init(M, D, G, bx); pg8::EpiResid<false, true> E{x, XR, MOD + 2 * D, nullptr}; pg8::gemm_phase<pg8::EpiResid<false, true>, pg8::StaticOrder, true, true>(lds, g, S, E); }
    xcd_barrier(bar);
    if constexpr (PHON(1)) norm_pass<0, true>(XR, a.in[7], MOD + 3 * D, MOD + 4 * D, H, nullptr, gw, NGW, lane);
    xcd_barrier(bar);
    if constexpr (PHON(5)) { pg8::Gemm g{H, WIN, M, 1280, D}; pg8::StaticOrder S; S.init(M, 1280, G, bx); pg8::EpiWin E{ZQ, ZKV, KPE, QG, KG, VTG, SSQQ, SSQKV, a.in[13], a.in[14], ROPEM, ROPEG};
      pg8::gemm_phase<pg8::EpiWin, pg8::StaticOrder, true, true>(lds, g, S, E); }
    xcd_barrier(bar);
    if constexpr (PHON(6)) { pg8::Gemm g{ZQ, WUQ, M, 768, 256}; pg8::StaticOrder S; S.init(M, 768, G, bx); pg8::EpiUq E{QM, SSQQ, ROPEM}; pg8::gemm_phase<pg8::EpiUq, pg8::StaticOrder, true, true>(lds, g, S, E); }
    __syncthreads();
    if constexpr (PHON(7)) { pg8::Gemm g{ZKV, WUKV, M, 1024, 128}; pg8::StaticOrder S; S.init(M, 1024, G, bx); pg8::EpiUkv E{KN, VTM, SSQKV}; pg8::gemm_phase<pg8::EpiUkv, pg8::StaticOrder, true, true>(lds, g, S, E); }
    xcd_barrier(bar);
    if constexpr (PHON(8)) for (int u = bx; u < 256; u += G) {
        const int b = u & 7, idx = u >> 3, qb = idx & 15, hh = idx >> 4;
        att::attn_unit<0>(lds, b, qb, hh, QM, KN, KPE, VTM, OB, RSO);
        att::attn_unit<1>(lds, b, qb, hh, QG, KG, KPE, VTG, OB, RSO);
    }
    xcd_barrier(bar);
    if constexpr (PHON(9)) { pg8::Gemm g{OB, WOUT, M, D, D}; pg8::StaticOrder S; S.init(M, D, G, bx); pg8::EpiResid<true, false> E{XR, XR, MOD + 5 * D, RSO}; pg8::gemm_phase<pg8::EpiResid<true, false>, pg8::StaticOrder, true, true>(lds, g, S, E); }
    xcd_barrier(bar);
    if constexpr (PHON(1)) norm_pass<0, true>(XR, a.in[18], MOD + 6 * D, MOD + 7 * D, H, nullptr, gw, NGW, lane);
    xcd_barrier(bar);
    if constexpr (PHON(2)) { pg8::Gemm g{H, WGU2, M, 2 * DFF, D}; pg8::StaticOrder S; S.init(M, 2 * DFF, G, bx); pg8::EpiSwiglu E{ACT}; pg8::gemm_phase<pg8::EpiSwiglu, pg8::StaticOrder, true, true>(lds, g, S, E); }
    xcd_barrier(bar);
    if constexpr (PHON(3)) { pg8::Gemm g{ACT, WD2, M, D, DFF}; pg8::StaticOrder S; S.init(M, D, G, bx); pg8::EpiResid<false, false> E{XR, XR, MOD + 8 * D, nullptr}; pg8::gemm_phase<pg8::EpiResid<false, false>, pg8::StaticOrder, true, true>(lds, g, S, E); }
    xcd_barrier(bar);
    if constexpr (PHON(1)) norm_pass<1, true>(XR, a.in[21], nullptr, nullptr, nullptr, a.out, gw, NGW, lane);
}

extern "C" void kernel_launch(void* const* d_in, const int* in_sizes, int n_in, void* d_out, int out_size, void* d_ws, size_t ws_size, hipStream_t stream) {
    static int grid_blocks = 0;
    if (grid_blocks == 0) {
        if (n_in != 22 || out_size != M * D || ws_size < WS_END) { fprintf(stderr, "kernel_launch: unexpected shapes (n_in %d, out %d, ws %zu)\n", n_in, out_size, ws_size); grid_blocks = -1; return; }
        int dev = 0, cus = 0, per_cu = 0;
        hipGetDevice(&dev);
        hipDeviceGetAttribute(&cus, hipDeviceAttributeMultiprocessorCount, dev);
        if (hipFuncSetAttribute((const void*)fwd_megakernel, hipFuncAttributeMaxDynamicSharedMemorySize, LDS_BYTES) != hipSuccess) { fprintf(stderr, "kernel_launch: hipFuncSetAttribute failed\n"); grid_blocks = -1; return; }
        if (hipOccupancyMaxActiveBlocksPerMultiprocessor(&per_cu, (const void*)fwd_megakernel, 512, LDS_BYTES) != hipSuccess || per_cu < 1) { fprintf(stderr, "kernel_launch: occupancy query gave %d\n", per_cu); per_cu = 1; }
        (void)hipGetLastError();
        grid_blocks = cus * per_cu;
    }
    if (grid_blocks < 0) return;
    hipMemsetAsync((char*)d_ws + WS_MOD, 0, MOD_ZERO_BYTES, stream);
    Args a{};
    for (int i = 0; i < 22; ++i) a.in[i] = (const float*)d_in[i];
    a.out = (float*)d_out; a.ws = (unsigned char*)d_ws;
    void* args[] = {&a};
    hipError_t e = hipLaunchCooperativeKernel((const void*)fwd_megakernel, dim3(grid_blocks), dim3(512), args, LDS_BYTES, stream);
    if (e != hipSuccess) fprintf(stderr, "cooperative launch failed: %s (grid %d)\n", hipGetErrorString(e), grid_blocks);
}
```

```cpp
#include <hip/hip_runtime.h>
#include <hip/hip_cooperative_groups.h>
#include <cstdio>
#include <cstdint>
namespace cg = cooperative_groups;

namespace pg8 {
#define PG8_LAS __attribute__((address_space(3)))
typedef unsigned short bf16_t;
typedef short bf16x8 __attribute__((ext_vector_type(8)));
typedef float f32x4 __attribute__((ext_vector_type(4)));
typedef unsigned u32x4 __attribute__((ext_vector_type(4)));
constexpr int BM = 256, BK = 64, HALF = 128, HTB = HALF * BK * 2  , STAGE_BYTES = 8 * HTB, NXCD = 8, WGM = 8;

__host__ __device__ __forceinline__ int lds_byte(int r, int c) { const int st = (r >> 4) * 2 + (c >> 5), rr = r & 15, cc = c & 31, ob = rr * 64 + cc * 2; return st * 1024 + (ob ^ (((ob >> 9) & 1) << 5)); }
__host__ __device__ __forceinline__ void stage_rc(int b, int& R, int& C) { const int st = b / 1024, sb = b % 1024, swz = sb ^ (((sb >> 9) & 1) << 5); R = (st >> 1) * 16 + swz / 64; C = (st & 1) * 32 + (swz % 64) / 2; }
__host__ __device__ __forceinline__ int perm32(int rho) { const int n = rho >> 4, i = rho & 15; return 8 * (i >> 2) + 4 * n + (i & 3); }

struct Unit { int pm, pn; };
struct Gemm { const bf16_t* A; const bf16_t* Bt; int M, N, K; };

struct StaticOrder {
    int nM, nN, nwg, G, c;
    __host__ __device__ void init(int M, int N, int G_, int c_) { nM = M / BM; nN = N / BM; nwg = nM * nN; G = G_; c = c_; }
    __host__ __device__ bool next(int i, Unit& u) const {
        const long L = (long)i * G + c; if (L >= nwg) return false;
        int wgid = (int)L; { const int q = nwg / NXCD, r = nwg % NXCD, xcd = wgid % NXCD, off = wgid / NXCD; wgid = (xcd < r ? xcd * (q + 1) : r * (q + 1) + (xcd - r) * q) + off; }
        const int nig = WGM * nN, gid = wgid / nig, fm = gid * WGM, gsz = (nM - fm) < WGM ? (nM - fm) : WGM;
        u.pm = fm + ((wgid % nig) % gsz); u.pn = (wgid % nig) / gsz; return true;
    }
    __device__ __forceinline__ void a_ready(const Unit&) const {}
    __device__ __forceinline__ void done(const Unit&) const {}
};

typedef float f32x2c_t __attribute__((ext_vector_type(2))); typedef __bf16 bf16x2c_t __attribute__((ext_vector_type(2)));
__device__ __forceinline__ unsigned cvt_pk_bf16(float lo, float hi) { f32x2c_t v = {lo, hi}; bf16x2c_t b = __builtin_convertvector(v, bf16x2c_t); return __builtin_bit_cast(unsigned, b); }
typedef unsigned u32x2 __attribute__((ext_vector_type(2)));
constexpr int MTOK = 32768, SEQL = 4096, NMODC = 9216;
constexpr float NEPS = 1e-6f;
constexpr float C2M = 0.10206207261596577f * 1.4426950408889634f;
constexpr float C2G = 0.125f * 1.4426950408889634f;
__device__ __forceinline__ unsigned short bf1(float v) { return (unsigned short)(cvt_pk_bf16(v, 0.f) & 0xffffu); }
typedef float f32x2s __attribute__((ext_vector_type(2)));
__device__ __forceinline__ unsigned swi2(float a0, float a1, float b0, float b1) {
    const f32x2s a = {a0, a1}, b = {b0, b1};
    f32x2s e; e.x = __builtin_amdgcn_exp2f(-a.x); e.y = __builtin_amdgcn_exp2f(-a.y);
    const f32x2s d = e + 1.0f; f32x2s r; r.x = __builtin_amdgcn_rcpf(d.x); r.y = __builtin_amdgcn_rcpf(d.y);
    const f32x2s o = (a * b) * r;
    return cvt_pk_bf16(o.x, o.y);
}
__device__ __forceinline__ float dot4(f32x4 v) { return (v[0] * v[0] + v[1] * v[1]) + (v[2] * v[2] + v[3] * v[3]); }
__device__ __forceinline__ float quad_sum(float s) { s += __shfl_xor(s, 16); s += __shfl_xor(s, 32); return s; }
__device__ __forceinline__ void st4(bf16_t* p, f32x4 v) { u32x2 w; w.x = cvt_pk_bf16(v[0], v[1]); w.y = cvt_pk_bf16(v[2], v[3]); *(u32x2*)p = w; }

struct EpiSwiglu {
    static constexpr bool PERM = true, AFTER_DRAIN = false; static constexpr int MIDT = -1;
    bf16_t* O;
    __device__ __forceinline__ void mid(f32x4 (&)[2][2][4][2], const Unit&, int, int) const {}
    __device__ __forceinline__ void operator()(const f32x4 (&acc)[2][2][4][2], const Unit& u, int wr, int wc, int fr, int fq) const {
        asm volatile("" : "+v"(fr), "+v"(fq));
        const int row0 = u.pm * BM + wr * 64 + fr, col0 = u.pn * 128 + wc * 32 + 8 * fq;
#pragma unroll
        for (int ai = 0; ai < 2; ++ai)
#pragma unroll
            for (int m = 0; m < 4; ++m) {
                bf16_t* rowp = O + (size_t)(row0 + ai * HALF + m * 16) * 2816 + col0;
                const f32x4 a0 = acc[ai][0][m][0], a1 = acc[ai][0][m][1], b0 = acc[ai][1][m][0], b1 = acc[ai][1][m][1];
                u32x4 w;
                w.x = swi2(a0[0], a0[1], b0[0], b0[1]); w.y = swi2(a0[2], a0[3], b0[2], b0[3]);
                w.z = swi2(a1[0], a1[1], b1[0], b1[1]); w.w = swi2(a1[2], a1[3], b1[2], b1[3]);
                *(u32x4*)rowp = w;
            }
    }
};
__device__ __forceinline__ f32x4 bf4_lo(u32x4 w) { return (f32x4){__uint_as_float(w.x << 16), __uint_as_float(w.x & 0xffff0000u), __uint_as_float(w.y << 16), __uint_as_float(w.y & 0xffff0000u)}; }
__device__ __forceinline__ f32x4 bf4_hi(u32x4 w) { return (f32x4){__uint_as_float(w.z << 16), __uint_as_float(w.z & 0xffff0000u), __uint_as_float(w.w << 16), __uint_as_float(w.w & 0xffff0000u)}; }
template <bool MIX, bool XF32> struct EpiResid {
    static constexpr bool PERM = true, AFTER_DRAIN = false; static constexpr int MIDT = MIX ? 8 : -1;
    const void* xin; bf16_t* xout; const float* gate; const float* rs2;
    __device__ __forceinline__ void mid(f32x4 (&acc)[2][2][4][2], const Unit& u, int wr, int fr) const {
        if constexpr (MIX) {
#pragma unroll
            for (int ai = 0; ai < 2; ++ai)
#pragma unroll
                for (int m = 0; m < 4; ++m) { const int row = u.pm * BM + wr * 64 + fr + ai * HALF + m * 16; const f32x4 sq = *(const f32x4*)(rs2 + 4 * row); const float q = sqrtf(((sq[2] + sq[3]) * (1.f / 512.f) + NEPS) / ((sq[0] + sq[1]) * (1.f / 512.f) + NEPS));
#pragma unroll
                    for (int bj = 0; bj < 2; ++bj)
#pragma unroll
                        for (int n = 0; n < 2; ++n) acc[ai][bj][m][n] *= q; }
        }
    }
    __device__ __forceinline__ void operator()(const f32x4 (&acc)[2][2][4][2], const Unit& u, int wr, int wc, int fr, int fq) const {
        asm volatile("" : "+v"(fr), "+v"(fq));
        const int row0 = u.pm * BM + wr * 64 + fr, col0 = u.pn * BM + wc * 32 + 8 * fq, b = u.pm >> 4;
        f32x4 gv[2][2];
#pragma unroll
        for (int bj = 0; bj < 2; ++bj)
#pragma unroll
            for (int n = 0; n < 2; ++n) gv[bj][n] = *(const f32x4*)(gate + (size_t)b * NMODC + col0 + bj * HALF + n * 4) * (MIX ? 1.0f : 0.5f);
#pragma unroll
        for (int ai = 0; ai < 2; ++ai)
#pragma unroll
            for (int m = 0; m < 4; ++m) { const int row = row0 + ai * HALF + m * 16; const size_t off = (size_t)row * 1024 + col0; float rs = 1.f; if constexpr (MIX) { const float* sp = rs2 + 4 * row + 2; rs = 1.0f / sqrtf((sp[0] + sp[1]) * (1.f / 512.f) + NEPS); }
#pragma unroll
                for (int bj = 0; bj < 2; ++bj) { f32x4 x0, x1;
                    if constexpr (XF32) { x0 = *(const f32x4*)((const float*)xin + off + bj * HALF); x1 = *(const f32x4*)((const float*)xin + off + bj * HALF + 4); }
                    else { const u32x4 w = *(const u32x4*)((const bf16_t*)xin + off + bj * HALF); x0 = bf4_lo(w); x1 = bf4_hi(w); }
                    const f32x4 o0 = x0 + gv[bj][0] * (acc[ai][bj][m][0] * rs), o1 = x1 + gv[bj][1] * (acc[ai][bj][m][1] * rs);
                    u32x4 w; w.x = cvt_pk_bf16(o0[0], o0[1]); w.y = cvt_pk_bf16(o0[2], o0[3]); w.z = cvt_pk_bf16(o1[0], o1[1]); w.w = cvt_pk_bf16(o1[2], o1[3]);
                    *(u32x4*)(xout + off + bj * HALF) = w; } }
    }
};
__device__ __forceinline__ void rope4(f32x4 x1, f32x4 x2, const float* cs, f32x4& y1, f32x4& y2) {
    const f32x4 t0 = *(const f32x4*)cs, t1 = *(const f32x4*)(cs + 4);
    const f32x4 c = {t0[0], t0[2], t1[0], t1[2]}, s = {t0[1], t0[3], t1[1], t1[3]};
    y1 = x1 * c - x2 * s; y2 = x1 * s + x2 * c;
}
struct EpiWin {
    static constexpr bool PERM = false, AFTER_DRAIN = false; static constexpr int MIDT = -1;
    bf16_t *ZQ, *ZKV, *KPE, *QG, *KG, *VTG; float *SSQQ, *SSQKV; const float *gq, *gk, *ropeM, *ropeG;
    __device__ __forceinline__ void mid(f32x4 (&)[2][2][4][2], const Unit&, int, int) const {}
    __device__ __forceinline__ void operator()(const f32x4 (&acc)[2][2][4][2], const Unit& u, int wr, int wc, int fr, int fq) const {
        asm volatile("" : "+v"(fr), "+v"(fq));
        const int row0 = u.pm * BM + wr * 64 + fr;
        if (u.pn == 0) {
#pragma unroll
            for (int ai = 0; ai < 2; ++ai)
#pragma unroll
                for (int m = 0; m < 4; ++m) { const int row = row0 + ai * HALF + m * 16; float s = 0.f;
#pragma unroll
                    for (int bj = 0; bj < 2; ++bj)
#pragma unroll
                        for (int n = 0; n < 2; ++n) { const f32x4 v = acc[ai][bj][m][n]; s += dot4(v); st4(ZQ + (size_t)row * 256 + bj * HALF + wc * 32 + n * 16 + 4 * fq, v); }
                    s = quad_sum(s); if (fq == 0) SSQQ[row * 4 + wc] = s; }
        } else if (u.pn <= 2 || (u.pn == 3 && wc < 2)) {
            const bool isq = u.pn <= 2; const float* g = isq ? gq : gk;
            bf16_t* dst = isq ? QG + (4 * (u.pn - 1) + wc) * 64 : KG + wc * 64; const int pitch = isq ? 512 : 128; const float osc = isq ? C2G : 1.f;
            f32x4 gv[2][2];
#pragma unroll
            for (int bj = 0; bj < 2; ++bj)
#pragma unroll
                for (int n = 0; n < 2; ++n) gv[bj][n] = *(const f32x4*)(g + 32 * bj + 16 * n + 4 * fq) * osc;
#pragma unroll
            for (int ai = 0; ai < 2; ++ai)
#pragma unroll
                for (int m = 0; m < 4; ++m) { const int row = row0 + ai * HALF + m * 16; float s = 0.f;
#pragma unroll
                    for (int bj = 0; bj < 2; ++bj)
#pragma unroll
                        for (int n = 0; n < 2; ++n) s += dot4(acc[ai][bj][m][n]);
                    s = quad_sum(s); const float rstd = 1.0f / sqrtf(s * (1.f / 64.f) + NEPS);
                    const int srow = row & (SEQL - 1), prow = srow >> 6, pcol = srow & 63;
#pragma unroll
                    for (int bj = 0; bj < 2; ++bj) { const int pos = bj ? pcol : prow; f32x4 y1, y2;
                        rope4(acc[ai][bj][m][0] * rstd * gv[bj][0], acc[ai][bj][m][1] * rstd * gv[bj][1], ropeG + (pos * 16 + 4 * fq) * 2, y1, y2);
                        bf16_t* dp = isq ? dst + (size_t)row * pitch : KG + ((((size_t)((row >> 12) * 2 + wc) * 64 + (srow >> 6)) * 64 + (srow & 63)) * 64);
                        st4(dp + 32 * bj + 4 * fq, y1); st4(dp + 32 * bj + 16 + 4 * fq, y2); } }
        } else if (u.pn == 3) {
            const int hk = wc - 2;
#pragma unroll
            for (int ai = 0; ai < 2; ++ai)
#pragma unroll
                for (int m = 0; m < 4; ++m) { const int row = row0 + ai * HALF + m * 16;
#pragma unroll
                    for (int bj = 0; bj < 2; ++bj)
#pragma unroll
                        for (int n = 0; n < 2; ++n)
#pragma unroll
                            for (int i = 0; i < 4; ++i) VTG[((((size_t)((row >> 12) * 2 + hk) * 64 + ((row & (SEQL - 1)) >> 6)) * 64 + (32 * bj + 16 * n + 4 * fq + i)) * 64) + (row & 63)] = bf1(acc[ai][bj][m][n][i]); }
        } else {
#pragma unroll
            for (int ai = 0; ai < 2; ++ai)
#pragma unroll
                for (int m = 0; m < 4; ++m) { const int row = row0 + ai * HALF + m * 16; float s = 0.f;
#pragma unroll
                    for (int n = 0; n < 2; ++n) { const f32x4 v = acc[ai][0][m][n]; s += dot4(v); st4(ZKV + (size_t)row * 128 + wc * 32 + n * 16 + 4 * fq, v); }
                    s = quad_sum(s); if (fq == 0) SSQKV[row * 4 + wc] = s;
                    if (wc == 0) { const int srow = row & (SEQL - 1), prow = srow >> 6, pcol = srow & 63; const int a = fq >> 1, e0 = 4 * (fq & 1), pos = a ? pcol : prow; f32x4 y1, y2;
                        rope4(acc[ai][1][m][0], acc[ai][1][m][1], ropeM + (pos * 8 + e0) * 2, y1, y2);
                        st4(KPE + (size_t)row * 32 + 16 * a + e0, y1); st4(KPE + (size_t)row * 32 + 16 * a + 8 + e0, y2); } }
        }
    }
};
struct EpiUq {
    static constexpr bool PERM = false, AFTER_DRAIN = false; static constexpr int MIDT = -1;
    bf16_t* QM; const float* SSQQ; const float* ropeM;
    __device__ __forceinline__ void mid(f32x4 (&)[2][2][4][2], const Unit&, int, int) const {}
    __device__ __forceinline__ void operator()(const f32x4 (&acc)[2][2][4][2], const Unit& u, int wr, int wc, int fr, int fq) const {
        asm volatile("" : "+v"(fr), "+v"(fq));
        const int row0 = u.pm * BM + wr * 64 + fr;
#pragma unroll
        for (int ai = 0; ai < 2; ++ai)
#pragma unroll
            for (int m = 0; m < 4; ++m) { const int row = row0 + ai * HALF + m * 16; const f32x4 sq = *(const f32x4*)(SSQQ + row * 4);
                const float sc = C2M / sqrtf(((sq[0] + sq[1]) + (sq[2] + sq[3])) * (1.f / 256.f) + NEPS);
                bf16_t* qrow = QM + (size_t)row * 768;
                if (u.pn < 2) {
#pragma unroll
                    for (int bj = 0; bj < 2; ++bj)
#pragma unroll
                        for (int n = 0; n < 2; ++n) { const int c = u.pn * BM + bj * HALF + wc * 32 + n * 16 + 4 * fq; st4(qrow + (c >> 6) * 96 + (c & 63), acc[ai][bj][m][n] * sc); }
                } else {
                    const int srow = row & (SEQL - 1), prow = srow >> 6, pcol = srow & 63; const int a = fq >> 1, e0 = 4 * (fq & 1), pos = a ? pcol : prow;
#pragma unroll
                    for (int bj = 0; bj < 2; ++bj) { f32x4 y1, y2; rope4(acc[ai][bj][m][0] * sc, acc[ai][bj][m][1] * sc, ropeM + (pos * 8 + e0) * 2, y1, y2);
                        bf16_t* hp = qrow + (4 * bj + wc) * 96 + 64; st4(hp + 16 * a + e0, y1); st4(hp + 16 * a + 8 + e0, y2); }
                } }
    }
};
struct EpiUkv {
    static constexpr bool PERM = false, AFTER_DRAIN = false; static constexpr int MIDT = -1;
    bf16_t *KN, *VTM; const float* SSQKV;
    __device__ __forceinline__ void mid(f32x4 (&)[2][2][4][2], const Unit&, int, int) const {}
    __device__ __forceinline__ void operator()(const f32x4 (&acc)[2][2][4][2], const Unit& u, int wr, int wc, int fr, int fq) const {
        asm volatile("" : "+v"(fr), "+v"(fq));
        const int row0 = u.pm * BM + wr * 64 + fr;
#pragma unroll
        for (int ai = 0; ai < 2; ++ai)
#pragma unroll
            for (int m = 0; m < 4; ++m) { const int row = row0 + ai * HALF + m * 16; const f32x4 sq = *(const f32x4*)(SSQKV + row * 4);
                const float sc = 1.0f / sqrtf(((sq[0] + sq[1]) + (sq[2] + sq[3])) * (1.f / 128.f) + NEPS);
                if (u.pn < 2) {
#pragma unroll
                    for (int bj = 0; bj < 2; ++bj)
#pragma unroll
                        for (int n = 0; n < 2; ++n) { const int c = u.pn * BM + bj * HALF + wc * 32 + n * 16 + 4 * fq; st4(KN + ((((size_t)((row >> 12) * 8 + (c >> 6)) * 64 + ((row & (SEQL - 1)) >> 6)) * 64 + (row & 63)) * 64) + (c & 63), acc[ai][bj][m][n] * sc); }
                } else {
#pragma unroll
                    for (int bj = 0; bj < 2; ++bj)
#pragma unroll
                        for (int n = 0; n < 2; ++n)
#pragma unroll
                            for (int i = 0; i < 4; ++i) { const int c = (u.pn - 2) * BM + bj * HALF + wc * 32 + n * 16 + 4 * fq + i; VTM[((((size_t)((row >> 12) * 8 + (c >> 6)) * 64 + ((row & (SEQL - 1)) >> 6)) * 64 + (c & 63)) * 64) + (row & 63)] = bf1(acc[ai][bj][m][n][i] * sc); }
                } }
    }
};
template <class Epi, class Sched, bool ALIGN_EPI = false, bool SP2 = false>
__device__ __forceinline__ void gemm_phase(PG8_LAS unsigned char* lds, const Gemm g, const Sched S, const Epi E) {
    int tid_ = threadIdx.x; asm volatile("" : "+v"(tid_));
    const int tid = tid_, wid = __builtin_amdgcn_readfirstlane(tid >> 6), lane = tid & 63, wr = wid >> 2, wc = wid & 3, fr = lane & 15, fq = lane >> 4;
    const int K = g.K, nt = K / BK;
    unsigned voffA[2], voffB[2];
#pragma unroll
    for (int i = 0; i < 2; ++i) { int R, C; stage_rc(tid * 16 + i * 8192, R, C); const int Rb = Epi::PERM ? ((R & ~31) + perm32(R & 31)) : R;
        voffA[i] = (unsigned)(R * K + C) * 2u; voffB[i] = (unsigned)(Rb * K + C) * 2u; }
    const size_t kstep = (size_t)(BK * 2);
    const size_t hstep = (size_t)HALF * K * 2;
    const size_t tstep = 2 * hstep;
    const unsigned ldsw = (unsigned)wid * 1024u;
    const int aoff = lds_byte(wr * 64 + fr, fq * 8), boff = lds_byte(wc * 32 + fr, fq * 8);
#define PG8_SA(b, h) (((b) * 2 + (h)) * HTB)
#define PG8_SB(b, h) ((4 + (b) * 2 + (h)) * HTB)
#define PG8_STAGE(bufoff, gbase, voff) do { _Pragma("unroll") for (int _i = 0; _i < 2; ++_i) \
        __builtin_amdgcn_global_load_lds((const unsigned*)((const char*)(gbase) + (voff)[_i]), (PG8_LAS unsigned*)(lds + (bufoff) + ldsw + _i * 8192), 16, 0, 0); } while (0)
#define PG8_LDA(dst, b, h) do { _Pragma("unroll") for (int m = 0; m < 4; ++m) _Pragma("unroll") for (int k = 0; k < 2; ++k) dst[m][k] = *(const PG8_LAS bf16x8*)(lds + PG8_SA(b, h) + aoff + m * 2048 + k * 1024); } while (0)
#define PG8_LDB(dst, b, h) do { _Pragma("unroll") for (int n = 0; n < 2; ++n) _Pragma("unroll") for (int k = 0; k < 2; ++k) dst[n][k] = *(const PG8_LAS bf16x8*)(lds + PG8_SB(b, h) + boff + n * 2048 + k * 1024); } while (0)
#define PG8_MMA(ai, bj, At, Bt) do { __builtin_amdgcn_s_setprio(1); _Pragma("unroll") for (int m = 0; m < 4; ++m) _Pragma("unroll") for (int n = 0; n < 2; ++n) _Pragma("unroll") for (int k = 0; k < 2; ++k) \
        acc[ai][bj][m][n] = __builtin_amdgcn_mfma_f32_16x16x32_bf16(Bt[n][k], At[m][k], acc[ai][bj][m][n], 0, 0, 0); __builtin_amdgcn_s_setprio(0); } while (0)
#define PG8_WAIT_V(n) asm volatile("s_waitcnt vmcnt(" #n ")" ::: "memory")
#define PG8_WAIT_L(n) asm volatile("s_waitcnt lgkmcnt(" #n ")" ::: "memory")
#define PG8_BAR __builtin_amdgcn_s_barrier()
#define PG8_SCHED __builtin_amdgcn_sched_barrier(0)
    Unit cur, nxt; int ui = 0;
    if (!S.next(0, cur)) return;
    f32x4 acc[2][2][4][2];
#pragma unroll
    for (int a = 0; a < 2; ++a)
#pragma unroll
        for (int b = 0; b < 2; ++b)
#pragma unroll
            for (int m = 0; m < 4; ++m)
#pragma unroll
                for (int n = 0; n < 2; ++n) acc[a][b][m][n] = (f32x4){0.f, 0.f, 0.f, 0.f};
    bf16x8 At[4][2], B0[2][2], B1[2][2];
    const char* cA = (const char*)g.A + (size_t)cur.pm * tstep; const char* cB = (const char*)g.Bt + (size_t)cur.pn * tstep;
    S.a_ready(cur);
    if constexpr (SP2) {
        PG8_STAGE(PG8_SB(0, 0), cB, voffB); PG8_STAGE(PG8_SB(0, 1), cB + hstep, voffB); PG8_STAGE(PG8_SA(0, 0), cA, voffA); PG8_STAGE(PG8_SA(0, 1), cA + hstep, voffA);
        if (wr == 1) PG8_BAR;
        PG8_WAIT_V(2); PG8_BAR;
        PG8_STAGE(PG8_SB(1, 0), cB + kstep, voffB); PG8_STAGE(PG8_SA(1, 0), cA + kstep, voffA); PG8_STAGE(PG8_SB(1, 1), cB + hstep + kstep, voffB);
        PG8_WAIT_V(6); PG8_BAR;
    } else {
        PG8_STAGE(PG8_SB(0, 0), cB, voffB); PG8_STAGE(PG8_SA(0, 0), cA, voffA); PG8_STAGE(PG8_SB(0, 1), cB + hstep, voffB); PG8_STAGE(PG8_SA(0, 1), cA + hstep, voffA);
        if (wr == 1) PG8_BAR;
        PG8_WAIT_V(4); PG8_BAR;
        PG8_STAGE(PG8_SB(1, 0), cB + kstep, voffB); PG8_STAGE(PG8_SA(1, 0), cA + kstep, voffA); PG8_STAGE(PG8_SB(1, 1), cB + hstep + kstep, voffB);
        PG8_WAIT_V(6); PG8_BAR;
    }
    for (;;) {
        const bool has_next = S.next(ui + 1, nxt);
        const char* nA = has_next ? (const char*)g.A + (size_t)nxt.pm * tstep : cA; const char* nB = has_next ? (const char*)g.Bt + (size_t)nxt.pn * tstep : cB;
        for (int t = 0; t < nt; t += 2) {
            if constexpr (Epi::MIDT >= 0) { if (t == Epi::MIDT) E.mid(acc, cur, wr, fr); }
            const bool last = (t == nt - 2);
            const char* a1 = cA + (size_t)(t + 1) * kstep;
            const char* a2 = last ? nA : cA + (size_t)(t + 2) * kstep; const char* b2 = last ? nB : cB + (size_t)(t + 2) * kstep;
            const char* a3 = a2 + kstep; const char* b3 = b2 + kstep;
            if (last && has_next) S.a_ready(nxt);
            if constexpr (SP2) {
            PG8_LDB(B0, 0, 0); PG8_LDB(B1, 0, 1); PG8_SCHED; PG8_LDA(At, 0, 0); PG8_STAGE(PG8_SA(1, 1), a1 + hstep, voffA);
            PG8_WAIT_V(8); PG8_WAIT_L(0); PG8_BAR; PG8_MMA(0, 0, At, B0); PG8_MMA(0, 1, At, B1); PG8_BAR; PG8_SCHED;
            PG8_LDA(At, 0, 1); PG8_STAGE(PG8_SB(0, 0), b2, voffB); PG8_STAGE(PG8_SB(0, 1), b2 + hstep, voffB); PG8_STAGE(PG8_SA(0, 0), a2, voffA);
            PG8_WAIT_V(8); PG8_WAIT_L(0); PG8_BAR; PG8_MMA(1, 0, At, B0); PG8_MMA(1, 1, At, B1); PG8_BAR; PG8_SCHED;
            PG8_LDB(B0, 1, 0); PG8_LDB(B1, 1, 1); PG8_SCHED; PG8_LDA(At, 1, 0); PG8_STAGE(PG8_SA(0, 1), a2 + hstep, voffA);
            PG8_WAIT_V(8); PG8_WAIT_L(0); PG8_BAR; PG8_MMA(0, 0, At, B0); PG8_MMA(0, 1, At, B1); PG8_BAR; PG8_SCHED;
            PG8_LDA(At, 1, 1); PG8_STAGE(PG8_SB(1, 0), b3, voffB); PG8_STAGE(PG8_SB(1, 1), b3 + hstep, voffB); PG8_STAGE(PG8_SA(1, 0), a3, voffA);
            PG8_WAIT_V(8); PG8_WAIT_L(0); PG8_BAR; PG8_MMA(1, 0, At, B0); PG8_MMA(1, 1, At, B1); PG8_BAR; PG8_SCHED;
            } else {
            PG8_LDB(B0, 0, 0); PG8_SCHED; PG8_LDA(At, 0, 0); PG8_STAGE(PG8_SA(1, 1), a1 + hstep, voffA);
            PG8_WAIT_L(8); PG8_BAR; PG8_WAIT_L(0); PG8_MMA(0, 0, At, B0); PG8_BAR; PG8_SCHED;
            PG8_LDB(B1, 0, 1); PG8_STAGE(PG8_SB(0, 0), b2, voffB);
            PG8_BAR; PG8_WAIT_L(0); PG8_MMA(0, 1, At, B1); PG8_BAR;
            PG8_LDA(At, 0, 1); PG8_STAGE(PG8_SA(0, 0), a2, voffA);
            PG8_BAR; PG8_WAIT_L(0); PG8_MMA(1, 0, At, B0); PG8_BAR; PG8_SCHED;
            PG8_STAGE(PG8_SB(0, 1), b2 + hstep, voffB);
            PG8_WAIT_V(6); PG8_BAR; PG8_MMA(1, 1, At, B1); PG8_BAR;
            PG8_LDB(B0, 1, 0); PG8_SCHED; PG8_LDA(At, 1, 0); PG8_STAGE(PG8_SA(0, 1), a2 + hstep, voffA);
            PG8_WAIT_L(8); PG8_BAR; PG8_WAIT_L(0); PG8_MMA(0, 0, At, B0); PG8_BAR; PG8_SCHED;
            PG8_LDB(B1, 1, 1); PG8_STAGE(PG8_SB(1, 0), b3, voffB);
            PG8_BAR; PG8_WAIT_L(0); PG8_MMA(0, 1, At, B1); PG8_BAR;
            PG8_LDA(At, 1, 1); PG8_STAGE(PG8_SA(1, 0), a3, voffA);
            PG8_BAR; PG8_WAIT_L(0); PG8_MMA(1, 0, At, B0); PG8_BAR; PG8_SCHED;
            PG8_STAGE(PG8_SB(1, 1), b3 + hstep, voffB);
            PG8_WAIT_V(6); PG8_BAR; PG8_MMA(1, 1, At, B1); PG8_BAR;
            }
        }
        if constexpr (ALIGN_EPI) { if (wr == 0) PG8_BAR; }
        if constexpr (!Epi::AFTER_DRAIN) { E(acc, cur, wr, wc, fr, fq); S.done(cur); }
        if (!has_next) break;
#pragma unroll
        for (int a = 0; a < 2; ++a)
#pragma unroll
            for (int b = 0; b < 2; ++b)
#pragma unroll
                for (int m = 0; m < 4; ++m)
#pragma unroll
                    for (int n = 0; n < 2; ++n) acc[a][b][m][n] = (f32x4){0.f, 0.f, 0.f, 0.f};
        cur = nxt; cA = nA; cB = nB; ++ui;
        if constexpr (ALIGN_EPI) { if (wr == 1) PG8_BAR; }
    }
    PG8_WAIT_V(0);
    if constexpr (!ALIGN_EPI) { if (wr == 0) PG8_BAR; }
    PG8_BAR;
    if constexpr (Epi::AFTER_DRAIN) { E.fused(acc, cur, wr, wc, fr, fq, lds, wid, lane); S.done(cur); }
#undef PG8_SA
#undef PG8_SB
#undef PG8_STAGE
#undef PG8_LDA
#undef PG8_LDB
#undef PG8_MMA
#undef PG8_WAIT_V
#undef PG8_WAIT_L
#undef PG8_BAR
#undef PG8_SCHED
}
}

#define LAS __attribute__((address_space(3)))
namespace att {
typedef unsigned short bf16_t;
typedef short bf16x8 __attribute__((ext_vector_type(8)));
typedef float f32x16 __attribute__((ext_vector_type(16)));
typedef float f32x4 __attribute__((ext_vector_type(4)));
typedef unsigned u32x4 __attribute__((ext_vector_type(4)));
typedef unsigned u32x2 __attribute__((ext_vector_type(2)));
constexpr int KST = 208, VST = 144, KBUF = 64 * KST, VBUF = 64 * VST;
constexpr int MTOK = 32768, SEQL = 4096;
constexpr float THR = 32.0f;
typedef float f32x2_t __attribute__((ext_vector_type(2))); typedef __bf16 bf16x2_t __attribute__((ext_vector_type(2)));
__device__ __forceinline__ unsigned cvtpk(float lo, float hi) { f32x2_t v = {lo, hi}; bf16x2_t b = __builtin_convertvector(v, bf16x2_t); return __builtin_bit_cast(unsigned, b); }
__device__ __forceinline__ float xhalf_max(float m) { auto rr = __builtin_amdgcn_permlane32_swap(__float_as_uint(m), __float_as_uint(m), false, false); return fmaxf(__uint_as_float(rr[0]), __uint_as_float(rr[1])); }
__device__ __forceinline__ float xhalf_sum(float m) { auto rr = __builtin_amdgcn_permlane32_swap(__float_as_uint(m), __float_as_uint(m), false, false); return __uint_as_float(rr[0]) + __uint_as_float(rr[1]); }
__device__ __forceinline__ float max3f(float a, float b, float c) { float r; asm("v_max3_f32 %0, %1, %2, %3" : "=v"(r) : "v"(a), "v"(b), "v"(c)); return r; }
__device__ __forceinline__ float max2f(float a, float b) { float r; asm("v_max_f32_e32 %0, %1, %2" : "=v"(r) : "v"(a), "v"(b)); return r; }
#define ATT_BAR() do { __builtin_amdgcn_sched_barrier(0); asm volatile("s_waitcnt lgkmcnt(0)\n\ts_barrier" ::: "memory"); __builtin_amdgcn_sched_barrier(0); } while (0)

template <int GRP> struct AttCtx {
    LAS unsigned char* lds; const bf16_t* Q; const bf16_t* KN; const bf16_t* KPE; const bf16_t* VT; bf16_t* O;
    const bf16_t *kl, *pl, *vl;
    size_t rowbase, qrow; int b, h0, tid, hi, kro, vro, kwo, pwo, vwo, kkey, kc, pkey, pc; bool trail;
};
template <int GRP> struct AttState {
    static constexpr int NKS = (GRP == 0 ? 96 : 64) / 16;
    bf16x8 qr[NKS]; f32x16 o0, o1; unsigned pw[16]; float mhat, lrun, ssq; int refnz;
};
template <int GRP> __device__ __forceinline__ void att_ldk(const AttCtx<GRP>& C, int step, u32x4& kreg, u32x4& preg) {
    const int h = C.h0 + (step >> 6), t = step & 63, kvh = GRP == 0 ? h : (h >> 2);
    kreg = *(const u32x4*)(C.kl + (kvh * 64 + t) * 4096);
    if (GRP == 0 && C.tid < 256) preg = *(const u32x4*)(C.pl + t * 2048);
}
template <int GRP> __device__ __forceinline__ void att_ldv(const AttCtx<GRP>& C, int step, u32x4& vreg) {
    const int h = C.h0 + (step >> 6), t = step & 63, kvh = GRP == 0 ? h : (h >> 2);
    vreg = *(const u32x4*)(C.vl + (kvh * 64 + t) * 4096);
}
template <int GRP> __device__ __forceinline__ void att_stk(const AttCtx<GRP>& C, int buf, const u32x4& kreg, const u32x4& preg) {
    *(LAS u32x4*)(C.lds + buf * KBUF + C.kwo) = kreg; if (GRP == 0 && C.tid < 256) *(LAS u32x4*)(C.lds + buf * KBUF + C.pwo) = preg;
}
template <int GRP> __device__ __forceinline__ void att_stv(const AttCtx<GRP>& C, int buf, const u32x4& vreg) { *(LAS u32x4*)(C.lds + buf * VBUF + C.vwo) = vreg; }
template <int GRP> __device__ __forceinline__ void att_stld(const AttCtx<GRP>& C, int s, u32x4& kreg, u32x4& preg, u32x4& vreg) {
    constexpr int NSTEP = 256;
    if (s + 2 < NSTEP) att_stk<GRP>(C, s & 1, kreg, preg);
    if (s + 1 < NSTEP) att_stv<GRP>(C, (s + 1) & 1, vreg);
    if (s + 3 < NSTEP) att_ldk<GRP>(C, s + 3, kreg, preg);
    if (s + 2 < NSTEP) att_ldv<GRP>(C, s + 2, vreg);
}
template <int GRP, int KS0, int N> __device__ __forceinline__ void att_kfrag(const AttCtx<GRP>& C, int slot, bf16x8 (&kf)[2 * N]) {
    const LAS unsigned char* kb = C.lds + slot * KBUF + C.kro;
#pragma unroll
    for (int i = 0; i < N; ++i) { kf[2 * i] = *(const LAS bf16x8*)(kb + (KS0 + i) * 32); kf[2 * i + 1] = *(const LAS bf16x8*)(kb + 32 * KST + (KS0 + i) * 32); }
}
template <int GRP> __device__ __forceinline__ void att_vfrag(const AttCtx<GRP>& C, int buf, bf16x8 (&vf)[8]) {
    const LAS unsigned char* vb = C.lds + buf * VBUF + C.vro;
#pragma unroll
    for (int ks = 0; ks < 4; ++ks) { vf[2 * ks] = *(const LAS bf16x8*)(vb + ks * 32); vf[2 * ks + 1] = *(const LAS bf16x8*)(vb + 32 * VST + ks * 32); }
}
template <int GRP> __device__ __forceinline__ void att_pv(AttState<GRP>& S, const bf16x8 (&vf)[8]) {
#pragma unroll
    for (int ks = 0; ks < 4; ++ks) { const u32x4 w = {S.pw[4 * ks], S.pw[4 * ks + 1], S.pw[4 * ks + 2], S.pw[4 * ks + 3]}; const bf16x8 pb = __builtin_bit_cast(bf16x8, w);
        S.o0 = __builtin_amdgcn_mfma_f32_32x32x16_bf16(vf[2 * ks], pb, S.o0, 0, 0, 0); S.o1 = __builtin_amdgcn_mfma_f32_32x32x16_bf16(vf[2 * ks + 1], pb, S.o1, 0, 0, 0); }
}
template <int GRP> __device__ __forceinline__ void att_finish_head(const AttCtx<GRP>& C, AttState<GRP>& S, int h) {
    const float inv = 1.0f / xhalf_sum(S.lrun);
    bf16_t* orow = C.O + C.qrow * 1024 + GRP * 512 + h * 64 + 4 * C.hi;
#pragma unroll
    for (int rr = 0; rr < 4; ++rr) {
        const f32x4 v0 = (f32x4){S.o0[4 * rr], S.o0[4 * rr + 1], S.o0[4 * rr + 2], S.o0[4 * rr + 3]} * inv, v1 = (f32x4){S.o1[4 * rr], S.o1[4 * rr + 1], S.o1[4 * rr + 2], S.o1[4 * rr + 3]} * inv;
        S.ssq += (v0[0] * v0[0] + v0[1] * v0[1]) + (v0[2] * v0[2] + v0[3] * v0[3]) + (v1[0] * v1[0] + v1[1] * v1[1]) + (v1[2] * v1[2] + v1[3] * v1[3]);
        u32x2 s0, s1; s0.x = cvtpk(v0[0], v0[1]); s0.y = cvtpk(v0[2], v0[3]); s1.x = cvtpk(v1[0], v1[1]); s1.y = cvtpk(v1[2], v1[3]);
        *(u32x2*)(orow + 8 * rr) = s0; *(u32x2*)(orow + 32 + 8 * rr) = s1;
    }
}
template <int GRP, bool has_next> __device__ __forceinline__ void att_step(const AttCtx<GRP>& C, AttState<GRP>& S, int s, f32x16& P0, f32x16& P1, f32x16& PN0, f32x16& PN1, u32x4& kreg, u32x4& preg, u32x4& vreg) {
    constexpr int DK = GRP == 0 ? 96 : 64, NKS = DK / 16, QP = GRP == 0 ? 768 : 512, NSTEP = 256, NK0 = NKS / 2, NK1 = NKS - NK0;
    const int h = C.h0 + (s >> 6), t = s & 63;
    bf16x8 kfa[2 * NK0], kfb[2 * NK1], vf[8];
    if (has_next) {
        if (t == 63) {
#pragma unroll
            for (int ks = 0; ks < NKS; ++ks) S.qr[ks] = *(const bf16x8*)(C.Q + C.qrow * QP + (h + 1) * DK + ks * 16 + C.hi * 8);
        }
        att_kfrag<GRP, 0, NK0>(C, (s + 1) & 1, kfa);
    }
    if (has_next) { PN0 = __builtin_amdgcn_mfma_f32_32x32x16_bf16(kfa[0], S.qr[0], (f32x16){}, 0, 0, 0); PN1 = __builtin_amdgcn_mfma_f32_32x32x16_bf16(kfa[1], S.qr[0], (f32x16){}, 0, 0, 0); }
    if ((t & 7) == 0) {
        float ma = max3f(P0[0], P0[1], P0[2]), mb = max3f(P0[3], P0[4], P0[5]), mc = max3f(P1[0], P1[1], P1[2]), md = max3f(P1[3], P1[4], P1[5]);
        ma = max3f(ma, P0[6], P0[7]); mb = max3f(mb, P0[8], P0[9]); mc = max3f(mc, P1[6], P1[7]); md = max3f(md, P1[8], P1[9]);
        ma = max3f(ma, P0[10], P0[11]); mb = max3f(mb, P0[12], P0[13]); mc = max3f(mc, P1[10], P1[11]); md = max3f(md, P1[12], P1[13]);
        ma = max3f(ma, P0[14], P0[15]); mc = max3f(mc, P1[14], P1[15]); ma = max3f(ma, mb, mc); mb = md;
        const float mx = xhalf_max(max2f(ma, mb));
        const int up = __any(mx > THR), dn = (t == 0) ? __any(mx < -THR) : 0;
        if (up | dn) {
            const float dl = ceilf((t == 0) ? mx : fmaxf(mx, 0.f));
            const float f = (t == 0) ? 0.f : __builtin_amdgcn_exp2f(-dl);
            S.mhat += dl; S.lrun *= f;
#pragma unroll
            for (int r = 0; r < 16; ++r) { P0[r] -= dl; P1[r] -= dl; S.o0[r] *= f; S.o1[r] *= f; }
            S.refnz = __any(S.mhat != 0.f);
        }
    }
    __builtin_amdgcn_sched_barrier(0);
    const unsigned mbits = (t == 63 || C.hi != 0) ? 0u : (__float_as_uint(-S.mhat) >> 16);
    const u32x4 qxw = {mbits, 0u, 0u, 0u}; const bf16x8 qx = __builtin_bit_cast(bf16x8, qxw);
    const bf16x8 ones = {0x3f80, 0x3f80, 0x3f80, 0x3f80, 0x3f80, 0x3f80, 0x3f80, 0x3f80};
    constexpr int NE = NKS - 1;
    float ra = 0.f, rb = 0.f, rc = 0.f, rd = 0.f;
#define ATT_SUMPACK(j) do { const float e0_ = (j) < 8 ? P0[2 * ((j) & 7)] : P1[2 * ((j) & 7)], e1_ = (j) < 8 ? P0[2 * ((j) & 7) + 1] : P1[2 * ((j) & 7) + 1]; \
        if ((j) & 1) { rc += e0_; rd += e1_; } else { ra += e0_; rb += e1_; } S.pw[j] = cvtpk(e0_, e1_); } while (0)
#pragma unroll
    for (int c = 1; c < NKS; ++c) {
        if (has_next) {
            if (c == NK0) att_kfrag<GRP, NK0, NK1>(C, (s + 1) & 1, kfb);
            const bf16x8 a0 = c < NK0 ? kfa[2 * c] : kfb[2 * (c - NK0)], a1 = c < NK0 ? kfa[2 * c + 1] : kfb[2 * (c - NK0) + 1];
            PN0 = __builtin_amdgcn_mfma_f32_32x32x16_bf16(a0, S.qr[c], PN0, 0, 0, 0); PN1 = __builtin_amdgcn_mfma_f32_32x32x16_bf16(a1, S.qr[c], PN1, 0, 0, 0);
        }
#pragma unroll
        for (int j = (c - 1) * 16 / NE; j < c * 16 / NE; ++j) {
            if (j < 8) { P0[2 * j] = __builtin_amdgcn_exp2f(P0[2 * j]); P0[2 * j + 1] = __builtin_amdgcn_exp2f(P0[2 * j + 1]); }
            else { P1[2 * (j - 8)] = __builtin_amdgcn_exp2f(P1[2 * (j - 8)]); P1[2 * (j - 8) + 1] = __builtin_amdgcn_exp2f(P1[2 * (j - 8) + 1]); }
        }
        if (c > 1) {
#pragma unroll
            for (int j = (c - 2) * 16 / NE; j < (c - 1) * 16 / NE; ++j) ATT_SUMPACK(j);
        }
        __builtin_amdgcn_sched_barrier(0);
    }
    if (has_next && S.refnz && t != 63) { PN0 = __builtin_amdgcn_mfma_f32_32x32x16_bf16(ones, qx, PN0, 0, 0, 0); PN1 = __builtin_amdgcn_mfma_f32_32x32x16_bf16(ones, qx, PN1, 0, 0, 0); }
    att_vfrag<GRP>(C, s & 1, vf);
#pragma unroll
    for (int j = (NE - 1) * 16 / NE; j < 16; ++j) ATT_SUMPACK(j);
#undef ATT_SUMPACK
    S.lrun += (ra + rb) + (rc + rd);
    att_pv<GRP>(S, vf);
    if (t == 63) {
        att_finish_head<GRP>(C, S, h);
        S.o0 = (f32x16){}; S.o1 = (f32x16){}; S.lrun = 0.f; S.mhat = 0.f; S.refnz = 0;
    }
    att_stld<GRP>(C, s, kreg, preg, vreg);
    ATT_BAR();
}
template <int GRP>
__device__ __forceinline__ void attn_unit(LAS unsigned char* lds, int b, int qb, int hh, const bf16_t* __restrict__ Q, const bf16_t* __restrict__ KN, const bf16_t* __restrict__ KPE,
                                          const bf16_t* __restrict__ VT, bf16_t* __restrict__ O, float* __restrict__ RS) {
    constexpr int DK = GRP == 0 ? 96 : 64, NKS = DK / 16, QP = GRP == 0 ? 768 : 512, NSTEP = 4 * 64;
    int tid_ = threadIdx.x; asm volatile("" : "+v"(tid_));
    const int tid = tid_, lane = tid & 63, r32 = lane & 31, hi = lane >> 5, wid = __builtin_amdgcn_readfirstlane(tid >> 6);
    AttCtx<GRP> C;
    C.b = b; C.h0 = 4 * hh; C.lds = lds; C.Q = Q; C.KN = KN; C.KPE = KPE; C.VT = VT; C.O = O; C.tid = tid; C.hi = hi; C.trail = false;
    C.rowbase = (size_t)b * SEQL; C.qrow = C.rowbase + (size_t)qb * 256 + wid * 32 + r32;
    const int pr = (r32 & 19) | ((r32 & 4) << 1) | ((r32 & 8) >> 1);
    C.kro = pr * KST + hi * 16; C.vro = 2 * KBUF + r32 * VST + hi * 16;
    C.kkey = tid >> 3; C.kc = tid & 7; C.pkey = (tid >> 2) & 63; C.pc = tid & 3;
    { constexpr int NHK = GRP == 0 ? 8 : 2; const size_t lo = (size_t)C.kkey * 64 + C.kc * 8;
      C.kl = KN + (size_t)(b * NHK) * 64 * 4096 + lo; C.vl = VT + (size_t)(b * NHK) * 64 * 4096 + lo; C.pl = KPE + (C.rowbase + C.pkey) * 32 + C.pc * 8; }
    C.kwo = C.kkey * KST + C.kc * 16; C.pwo = C.pkey * KST + 128 + C.pc * 16; C.vwo = 2 * KBUF + C.kkey * VST + C.kc * 16;
    u32x4 kA, pA = {0u, 0u, 0u, 0u}, vA;
    AttState<GRP> S;
    S.o0 = (f32x16){}; S.o1 = (f32x16){}; S.mhat = 0.f; S.lrun = 0.f; S.ssq = 0.f; S.refnz = 0;
#pragma unroll
    for (int i = 0; i < 16; ++i) S.pw[i] = 0u;
    { u32x4 kB, pB = {0u, 0u, 0u, 0u};
      att_ldk<GRP>(C, 0, kA, pA); att_ldk<GRP>(C, 1, kB, pB); att_ldv<GRP>(C, 0, vA);
      att_stk<GRP>(C, 0, kA, pA); att_stk<GRP>(C, 1, kB, pB); att_stv<GRP>(C, 0, vA); }
    att_ldk<GRP>(C, 2, kA, pA); att_ldv<GRP>(C, 1, vA);
#pragma unroll
    for (int ks = 0; ks < NKS; ++ks) S.qr[ks] = *(const bf16x8*)(Q + C.qrow * QP + C.h0 * DK + ks * 16 + hi * 8);
    ATT_BAR();
    f32x16 pa0 = {}, pa1 = {}, pb0 = {}, pb1 = {};
    {
        bf16x8 kf[2 * NKS]; att_kfrag<GRP, 0, NKS>(C, 0, kf);
#pragma unroll
        for (int ks = 0; ks < NKS; ++ks) { pa0 = __builtin_amdgcn_mfma_f32_32x32x16_bf16(kf[2 * ks], S.qr[ks], pa0, 0, 0, 0); pa1 = __builtin_amdgcn_mfma_f32_32x32x16_bf16(kf[2 * ks + 1], S.qr[ks], pa1, 0, 0, 0); }
    }
    if (wid >= 4) __builtin_amdgcn_s_setprio(1);
    asm volatile("s_nop 15\n\ts_nop 7" : "+v"(pa0), "+v"(pa1));
    for (int s = 0; s < NSTEP - 2; s += 2) { att_step<GRP, true>(C, S, s, pa0, pa1, pb0, pb1, kA, pA, vA); att_step<GRP, true>(C, S, s + 1, pb0, pb1, pa0, pa1, kA, pA, vA); }
    att_step<GRP, true>(C, S, NSTEP - 2, pa0, pa1, pb0, pb1, kA, pA, vA); att_step<GRP, false>(C, S, NSTEP - 1, pb0, pb1, pa0, pa1, kA, pA, vA);
    __builtin_amdgcn_s_setprio(0);
    const float ssq = xhalf_sum(S.ssq);
    if (hi == 0) RS[C.qrow * 4 + GRP * 2 + hh] = ssq;
    __syncthreads();
}
}

typedef unsigned short bf16;
typedef float f32x4 __attribute__((ext_vector_type(4)));
typedef unsigned v4u __attribute__((ext_vector_type(4)));
typedef unsigned v2u __attribute__((ext_vector_type(2)));
constexpr int M = 32768, SEQ = 4096, D = 1024, DFF = 2816, DIN = 1184, NMOD9 = 9216;
constexpr size_t MiB = 1u << 20;
constexpr size_t WS_MOD = 0, MOD_ZERO_BYTES = 512 * 1024;
constexpr size_t WS_ROPEM = 1 * MiB, WS_ROPEG = 1 * MiB + 65536;
constexpr size_t WS_WGU1 = 2 * MiB, WS_WD1 = 14 * MiB, WS_WGU2 = 20 * MiB, WS_WD2 = 32 * MiB, WS_WIN = 38 * MiB, WS_WUQ = 41 * MiB, WS_WUKV = 42 * MiB, WS_WOUT = 43 * MiB;
constexpr size_t WS_SSQQ = 46 * MiB, WS_SSQKV = 47 * MiB, WS_RSO = 48 * MiB, WS_KPE = 50 * MiB;
constexpr size_t WS_H = 64 * MiB, WS_ACT = 128 * MiB, WS_XR = 304 * MiB;
constexpr size_t WS_QM = 128 * MiB, WS_KN = 176 * MiB, WS_VTM = 208 * MiB, WS_O = 240 * MiB;
constexpr size_t WS_ZQ = 432 * MiB, WS_ZKV = 448 * MiB, WS_QG = 456 * MiB, WS_KG = 488 * MiB, WS_VTG = 496 * MiB, WS_END = 504 * MiB;
constexpr int LDS_BYTES = 131072 + 64, LDS_BARST = 131072;
constexpr size_t WS_BAR = 384 * 1024;

__device__ __forceinline__ unsigned f2bf(float f) { unsigned u = __builtin_bit_cast(unsigned, f); return (u + 0x7fffu + ((u >> 16) & 1u)) >> 16; }
__device__ __forceinline__ unsigned pk2(float lo, float hi) { return f2bf(lo) | (f2bf(hi) << 16); }
#define LDS_WAIT() asm volatile("s_waitcnt lgkmcnt(0)" ::: "memory")
__device__ __forceinline__ float wave_sum(float v) {
#pragma unroll
    for (int o = 1; o < 64; o <<= 1) v += __shfl_xor(v, o);
    return v;
}
struct RmId { __device__ __forceinline__ int operator()(int n) const { return n; } __device__ __forceinline__ float scale(int) const { return 1.0f; } };
struct RmGu { __device__ __forceinline__ int operator()(int n) const { const int up = n >= DFF, j = up ? n - DFF : n; return 256 * (j >> 7) + 128 * up + (j & 127); }
              __device__ __forceinline__ float scale(int n) const { return n >= DFF ? 0.6931471805599453f : 1.4426950408889634f; } };
struct RmWin { __device__ __forceinline__ int operator()(int c) const {
    if (c < 256) return c;
    if (c < 384) return 1024 + (c - 256);
    if (c < 416) { const int d = c - 384, a = d >> 4, p = (d >> 3) & 1, e = d & 7; return 1024 + 128 + 16 * p + 8 * a + e; }
    if (c < 928) { const int h = (c - 416) >> 6, d = (c - 416) & 63; return 256 * (1 + (h >> 2)) + 128 * (d >> 5) + 32 * (h & 3) + (d & 31); }
    if (c < 1056) { const int hk = (c - 928) >> 6, d = (c - 928) & 63; return 768 + 128 * (d >> 5) + 32 * hk + (d & 31); }
    { const int hk = (c - 1056) >> 6, e = (c - 1056) & 63; return 768 + 128 * (e >> 5) + 32 * (2 + hk) + (e & 31); } }  __device__ __forceinline__ float scale(int) const { return 1.0f; } };
struct RmUq { __device__ __forceinline__ int operator()(int c) const { const int h = c / 96, j = c % 96; if (j < 64) return h * 64 + j; const int d = j - 64, a = d >> 4, p = (d >> 3) & 1, e = d & 7; return 512 + 32 * h + 16 * p + 8 * a + e; }  __device__ __forceinline__ float scale(int) const { return 1.0f; } };
struct RmUkv { __device__ __forceinline__ int operator()(int c) const { const int h = c >> 7, j = c & 127; return j < 64 ? h * 64 + j : 512 + h * 64 + (j - 64); }  __device__ __forceinline__ float scale(int) const { return 1.0f; } };

template <class RM> __device__ __forceinline__ void tr_item(const float* __restrict__ W, int K, int N, bf16* __restrict__ WT, RM rm, const float* ks0, const float* ks1, int ksplit, LAS float* scr, int item, int lane) {
    const int nblk = N / 32, kb = item / nblk, nb = item % nblk, k0 = 64 * kb, n0 = 32 * nb;
    f32x4 wv[8];
    const int r8 = lane >> 3, cg = lane & 7;
#pragma unroll
    for (int i = 0; i < 8; ++i) wv[i] = *(const f32x4*)(W + (size_t)(k0 + 8 * i + r8) * N + n0 + 4 * cg);
    const f32x4 cs = {rm.scale(n0 + 4 * cg), rm.scale(n0 + 4 * cg + 1), rm.scale(n0 + 4 * cg + 2), rm.scale(n0 + 4 * cg + 3)};
#pragma unroll
    for (int i = 0; i < 8; ++i) { const int kk = 8 * i + r8; f32x4 w = wv[i] * cs;
        if (ks0) { const int k = k0 + kk; w = w * ((k < ksplit) ? ks0[k] : ks1[k - ksplit]); }
        scr[kk * 33 + 4 * cg] = w[0]; scr[kk * 33 + 4 * cg + 1] = w[1]; scr[kk * 33 + 4 * cg + 2] = w[2]; scr[kk * 33 + 4 * cg + 3] = w[3]; }
    LDS_WAIT(); asm volatile("" ::: "memory");
    const int c = lane & 7;
#pragma unroll
    for (int j = 0; j < 4; ++j) { const int n = (lane >> 3) + 8 * j; const LAS float* s = scr + (8 * c) * 33 + n;
        v4u o; o.x = pk2(s[0 * 33], s[1 * 33]); o.y = pk2(s[2 * 33], s[3 * 33]); o.z = pk2(s[4 * 33], s[5 * 33]); o.w = pk2(s[6 * 33], s[7 * 33]);
        *(v4u*)(WT + (size_t)rm(n0 + n) * K + k0 + 8 * c) = o; }
    LDS_WAIT(); asm volatile("" ::: "memory");
}
__device__ __forceinline__ void mod_item(const float* __restrict__ c, const float* __restrict__ wada, const float* __restrict__ bada, float* MOD, LAS float* scr, int item, int lane) {
    const int cgp = item % 144, kc = item / 144, n = cgp * 64 + lane, k0 = kc * 128;
#pragma unroll
    for (int i = 0; i < 16; ++i) { const int idx = i * 64 + lane, b = idx >> 7, kk = idx & 127; const float v = c[b * D + k0 + kk]; scr[idx] = v / (1.0f + expf(-v)); }
    LDS_WAIT(); asm volatile("" ::: "memory");
    float acc[8];
#pragma unroll
    for (int b = 0; b < 8; ++b) acc[b] = 0.f;
    for (int kq = 0; kq < 128; kq += 32) {
        float wv[32];
#pragma unroll
        for (int i = 0; i < 32; ++i) wv[i] = wada[(size_t)(k0 + kq + i) * NMOD9 + n];
#pragma unroll
        for (int i = 0; i < 32; ++i)
#pragma unroll
            for (int b = 0; b < 8; ++b) acc[b] += scr[b * 128 + kq + i] * wv[i];
    }
    if (kc == 0) { const float bb = bada[n];
#pragma unroll
        for (int b = 0; b < 8; ++b) acc[b] += bb; }
#pragma unroll
    for (int b = 0; b < 8; ++b) atomicAdd(MOD + b * NMOD9 + n, acc[b]);
    LDS_WAIT(); asm volatile("" ::: "memory");
}
template <int MODE, bool XB> __device__ __forceinline__ void norm_pass(const void* __restrict__ X, const float* __restrict__ g, const float* __restrict__ shift, const float* __restrict__ scale,
                                                             bf16* __restrict__ Hb, float* __restrict__ Of, int gw, int NGW, int lane) {
    asm volatile("" : "+v"(lane));
    for (int m0 = gw * 16; m0 < M; m0 += NGW * 16) {
        const int b = m0 / SEQ;
        f32x4 gm[4], sh[4];
#pragma unroll
        for (int j = 0; j < 4; ++j) { const int col = 4 * lane + 256 * j; gm[j] = *(const f32x4*)(g + col);
            if (MODE == 0) { gm[j] = gm[j] * (*(const f32x4*)(scale + (size_t)b * NMOD9 + col) + 1.0f); sh[j] = *(const f32x4*)(shift + (size_t)b * NMOD9 + col); } }
        for (int r = 0; r < 16; ++r) {
            f32x4 v[4]; float s = 0.f;
#pragma unroll
            for (int j = 0; j < 4; ++j) {
                if constexpr (XB) { const v2u w = *(const v2u*)((const bf16*)X + (size_t)(m0 + r) * D + 4 * lane + 256 * j);
                    v[j] = (f32x4){__uint_as_float(w.x << 16), __uint_as_float(w.x & 0xffff0000u), __uint_as_float(w.y << 16), __uint_as_float(w.y & 0xffff0000u)}; }
                else v[j] = *(const f32x4*)((const float*)X + (size_t)(m0 + r) * D + 4 * lane + 256 * j);
                s += (v[j][0] * v[j][0] + v[j][1] * v[j][1]) + (v[j][2] * v[j][2] + v[j][3] * v[j][3]); }
            const float rstd = 1.0f / sqrtf(wave_sum(s) * (1.f / D) + 1e-6f);
#pragma unroll
            for (int j = 0; j < 4; ++j) {
                if (MODE == 0) { const f32x4 o = v[j] * rstd * gm[j] + sh[j]; v2u w; w.x = pk2(o[0], o[1]); w.y = pk2(o[2], o[3]); *(v2u*)(Hb + (size_t)(m0 + r) * D + 4 * lane + 256 * j) = w; }
                else { __builtin_nontemporal_store(v[j] * rstd * gm[j], (f32x4*)(Of + (size_t)(m0 + r) * D + 4 * lane + 256 * j)); }
            }
        }
    }
}

#define XB_TMO      128
#define XB_XCNT(j)  (256  + 64 * (j))
#define XB_XSUB(j)  (1280 + 64 * (j))
#define XB_XGEN(j)  (2304 + 64 * (j))
#define XB_TOP      3328
#define XB_TOPGEN   3392
#define XCD_BAR_WORDS 3456
#define XB_SPIN_CAP (1u << 24)

__device__ __forceinline__ unsigned xb_ld(unsigned* p)              { return __hip_atomic_load(p, __ATOMIC_RELAXED, __HIP_MEMORY_SCOPE_AGENT); }
__device__ __forceinline__ unsigned xb_add(unsigned* p, unsigned v) { return __hip_atomic_fetch_add(p, v, __ATOMIC_RELAXED, __HIP_MEMORY_SCOPE_AGENT); }
__device__ __forceinline__ unsigned xb_xcc_id() { return (unsigned)__builtin_amdgcn_s_getreg((3 << 11) | 20) & 0xFu; }
#define XB_SPIN(cond, bar) do { unsigned _sp = 0; while (cond) { __builtin_amdgcn_s_sleep(1); \
    if ((++_sp & 255u) == 0u) { if (xb_ld(&(bar)[XB_TMO])) break; if (_sp > XB_SPIN_CAP) { atomicAdd(&(bar)[XB_TMO], 1u); break; } } } } while (0)
struct XcdBarrier {
    unsigned* bar; unsigned x;
    volatile LAS unsigned* st;
};

__device__ __forceinline__ XcdBarrier xcd_barrier_post(unsigned* bar, volatile LAS unsigned* st) {
    XcdBarrier b; b.bar = bar; b.x = xb_xcc_id(); b.st = st;
    if (threadIdx.x == 0) (void)xb_add(&bar[XB_XCNT(b.x)], 1u);
    return b;
}
__device__ __forceinline__ void xcd_barrier_complete(unsigned* bar, unsigned x, unsigned& nloc, unsigned& nx) {
    const unsigned G = gridDim.x * gridDim.y * gridDim.z;
    unsigned sum, cnt, mine, sp = 0u;
    for (;;) {
        sum = 0u; cnt = 0u; mine = 0u;
#pragma unroll
        for (unsigned j = 0; j < 16; ++j) { const unsigned c = xb_ld(&bar[XB_XCNT(j)]); sum += c; cnt += (c > 0u) ? 1u : 0u; mine = (j == x) ? c : mine; }
        if (sum == G) break;
        __builtin_amdgcn_s_sleep(1);
        if ((++sp & 255u) == 0u) { if (xb_ld(&bar[XB_TMO])) break; if (sp > XB_SPIN_CAP) { atomicAdd(&bar[XB_TMO], 1u); break; } }
    }
    nloc = mine > 0u ? mine : 1u; nx = cnt > 0u ? cnt : 1u;
}

__device__ __forceinline__ void xcd_barrier(const XcdBarrier& b) {
    asm volatile("s_waitcnt vmcnt(0)" ::: "memory");
    __syncthreads();
    if (threadIdx.x == 0) {
        unsigned* bar = b.bar;
        __builtin_amdgcn_s_waitcnt(0);
        unsigned nloc = b.st[0], nx = b.st[1];
        if (nloc == 0u) { xcd_barrier_complete(bar, b.x, nloc, nx); b.st[0] = nloc; b.st[1] = nx; }
        const unsigned old = xb_add(&bar[XB_XSUB(b.x)], 1u);
        const unsigned gen = old / nloc;
        if (old + 1u == (gen + 1u) * nloc) {
            __builtin_amdgcn_fence(__ATOMIC_RELEASE, "agent");
            asm volatile("s_waitcnt vmcnt(0)" ::: "memory");
            const unsigned og = xb_add(&bar[XB_TOP], 1u);
            const unsigned tg = og / nx;
            if (og + 1u == (tg + 1u) * nx) xb_add(&bar[XB_TOPGEN], 1u);
            else XB_SPIN(xb_ld(&bar[XB_TOPGEN]) == tg, bar);
            __builtin_amdgcn_fence(__ATOMIC_ACQUIRE, "agent");
            xb_add(&bar[XB_XGEN(b.x)], 1u);
            asm volatile("s_waitcnt vmcnt(0)" ::: "memory");
        } else {
            XB_SPIN(xb_ld(&bar[XB_XGEN(b.x)]) == gen, bar);
            __builtin_amdgcn_fence(__ATOMIC_ACQUIRE, "agent");
            asm volatile("s_waitcnt vmcnt(0)" ::: "memory");
        }
    }
    __syncthreads();
}


#ifndef ONLY_PHASE
#define ONLY_PHASE -1
#endif
#define PHON(k) (ONLY_PHASE < 0 || ONLY_PHASE == (k))
struct Args { const float* in[22]; float* out; unsigned char* ws; };
__global__ void __launch_bounds__(512) fwd_megakernel(Args a) {
    extern __shared__ __attribute__((aligned(16))) unsigned char lds_raw[];
    LAS unsigned char* lds = (LAS unsigned char*)lds_raw;
    cg::grid_group grid = cg::this_grid();
    const int tid = threadIdx.x, lane = tid & 63, wave = __builtin_amdgcn_readfirstlane(tid >> 6);
    const int G = gridDim.x, bx = blockIdx.x, gw = bx * 8 + wave, NGW = G * 8;
    unsigned char* ws = a.ws;
    float* MOD = (float*)(ws + WS_MOD); float* ROPEM = (float*)(ws + WS_ROPEM); float* ROPEG = (float*)(ws + WS_ROPEG);
    bf16 *WGU1 = (bf16*)(ws + WS_WGU1), *WD1 = (bf16*)(ws + WS_WD1), *WGU2 = (bf16*)(ws + WS_WGU2), *WD2 = (bf16*)(ws + WS_WD2), *WIN = (bf16*)(ws + WS_WIN), *WUQ = (bf16*)(ws + WS_WUQ), *WUKV = (bf16*)(ws + WS_WUKV), *WOUT = (bf16*)(ws + WS_WOUT);
    float *SSQQ = (float*)(ws + WS_SSQQ), *SSQKV = (float*)(ws + WS_SSQKV), *RSO = (float*)(ws + WS_RSO), *XRf_unused = nullptr; bf16* XR = (bf16*)(ws + WS_XR);
    bf16 *KPE = (bf16*)(ws + WS_KPE), *H = (bf16*)(ws + WS_H), *ACT = (bf16*)(ws + WS_ACT), *QM = (bf16*)(ws + WS_QM), *KN = (bf16*)(ws + WS_KN), *VTM = (bf16*)(ws + WS_VTM), *OB = (bf16*)(ws + WS_O);
    bf16 *ZQ = (bf16*)(ws + WS_ZQ), *ZKV = (bf16*)(ws + WS_ZKV), *QG = (bf16*)(ws + WS_QG), *KG = (bf16*)(ws + WS_KG), *VTG = (bf16*)(ws + WS_VTG);
    const float* x = a.in[0];
    if (tid < 16) ((LAS unsigned*)(lds + LDS_BARST))[tid] = 0u;
    __syncthreads();
    const XcdBarrier bar = xcd_barrier_post((unsigned*)(ws + WS_BAR), (volatile LAS unsigned*)(lds + LDS_BARST));

    if constexpr (PHON(0)) {
        LAS float* scr = (LAS float*)(lds + wave * 16384);
        for (int it = gw; it < 1152; it += NGW) mod_item(a.in[1], a.in[2], a.in[3], MOD, scr, it, lane);
        for (int i = bx * 512 + tid; i < 96 * 1024 / 8; i += G * 512) *(v4u*)(WIN + (size_t)1184 * D + (size_t)i * 8) = (v4u){0u, 0u, 0u, 0u};
        for (int i = bx * 512 + tid; i < 64 * 8 + 64 * 16; i += G * 512) {
            if (i < 512) { const int pos = i >> 3, e = i & 7; const float inv = powf(10000.0f, -((float)e * 2.0f / 16.0f)), ang = (float)pos * inv; ROPEM[2 * i] = cosf(ang); ROPEM[2 * i + 1] = sinf(ang); }
            else { const int k = i - 512, pos = k >> 4, f = k & 15; const float inv = powf(10000.0f, -((float)f * 2.0f / 32.0f)), ang = (float)pos * inv; ROPEG[2 * k] = cosf(ang); ROPEG[2 * k + 1] = sinf(ang); }
        }
    }
    grid.sync();
    if constexpr (PHON(1)) norm_pass<0, false>(x, a.in[4], MOD + 0 * D, MOD + 1 * D, H, nullptr, gw, NGW, lane);
    if constexpr (PHON(0)) {
        LAS float* scr = (LAS float*)(lds + wave * 16384);
        constexpr int I_GU = 16 * 176, I_DN = 44 * 32, I_IN = 16 * 37, I_UQ = 4 * 24, I_UKV = 2 * 32, I_OUT = 16 * 32;
        constexpr int NITEMS = 2 * (I_GU + I_DN) + I_IN + I_UQ + I_UKV + I_OUT;
        for (int it = gw; it < NITEMS; it += NGW) {
            int r = it;
            if (r < I_GU) { tr_item(a.in[5], D, 2 * DFF, WGU1, RmGu{}, nullptr, nullptr, 0, scr, r, lane); continue; } r -= I_GU;
            if (r < I_DN) { tr_item(a.in[6], DFF, D, WD1, RmId{}, nullptr, nullptr, 0, scr, r, lane); continue; } r -= I_DN;
            if (r < I_GU) { tr_item(a.in[19], D, 2 * DFF, WGU2, RmGu{}, nullptr, nullptr, 0, scr, r, lane); continue; } r -= I_GU;
            if (r < I_DN) { tr_item(a.in[20], DFF, D, WD2, RmId{}, nullptr, nullptr, 0, scr, r, lane); continue; } r -= I_DN;
            if (r < I_IN) { tr_item(a.in[8], D, DIN, WIN, RmWin{}, nullptr, nullptr, 0, scr, r, lane); continue; } r -= I_IN;
            if (r < I_UQ) { tr_item(a.in[10], 256, 768, WUQ, RmUq{}, a.in[9], a.in[9], 256, scr, r, lane); continue; } r -= I_UQ;
            if (r < I_UKV) { tr_item(a.in[12], 128, 1024, WUKV, RmUkv{}, a.in[11], a.in[11], 128, scr, r, lane); continue; } r -= I_UKV;
            tr_item(a.in[17], D, D, WOUT, RmId{}, a.in[15], a.in[16], 512, scr, r, lane);
        }
    }
    xcd_barrier(bar);
    if constexpr (PHON(2)) { pg8::Gemm g{H, WGU1, M, 2 * DFF, D}; pg8::StaticOrder S; S.init(M, 2 * DFF, G, bx); pg8::EpiSwiglu E{ACT}; pg8::gemm_phase<pg8::EpiSwiglu, pg8::StaticOrder, true, true>(lds, g, S, E); }
    xcd_barrier(bar);
    if constexpr (PHON(3)) { pg8::Gemm g{ACT, WD1, M, D, DFF}; pg8::StaticOrder S; S.init(M, D, G, bx); pg8::EpiResid<false, true> E{x, XR, MOD + 2 * D, nullptr}; pg8::gemm_phase<pg8::EpiResid<false, true>, pg8::StaticOrder, true, true>(lds, g, S, E); }
    xcd_barrier(bar);
    if constexpr (PHON(1)) norm_pass<0, true>(XR, a.in[7], MOD + 3 * D, MOD + 4 * D, H, nullptr, gw, NGW, lane);
    xcd_barrier(bar);
    if constexpr (PHON(5)) { pg8::Gemm g{H, WIN, M, 1280, D}; pg8::StaticOrder S; S.init(M, 1280, G, bx); pg8::EpiWin E{ZQ, ZKV, KPE, QG, KG, VTG, SSQQ, SSQKV, a.in[13], a.in[14], ROPEM, ROPEG};
      pg8::gemm_phase<pg8::EpiWin, pg8::StaticOrder, true, true>(lds, g, S, E); }
    xcd_barrier(bar);
    if constexpr (PHON(6)) { pg8::Gemm g{ZQ, WUQ, M, 768, 256}; pg8::StaticOrder S; S.init(M, 768, G, bx); pg8::EpiUq E{QM, SSQQ, ROPEM}; pg8::gemm_phase<pg8::EpiUq, pg8::StaticOrder, true, true>(lds, g, S, E); }
    __syncthreads();
    if constexpr (PHON(7)) { pg8::Gemm g{ZKV, WUKV, M, 1024, 128}; pg8::StaticOrder S; S.init(M, 1024, G, bx); pg8::EpiUkv E{KN, VTM, SSQKV}; pg8::gemm_phase<pg8::EpiUkv, pg8::StaticOrder, true, true>(lds, g, S, E); }
    xcd_barrier(bar);
    if constexpr (PHON(8)) for (int u = bx; u < 256; u += G) {
        const int b = u & 7, idx = u >> 3, qb = idx & 15, hh = idx >> 4;
        att::attn_unit<0>(lds, b, qb, hh, QM, KN, KPE, VTM, OB, RSO);
        att::attn_unit<1>(lds, b, qb, hh, QG, KG, KPE, VTG, OB, RSO);
    }
    xcd_barrier(bar);
    if constexpr (PHON(9)) { pg8::Gemm g{OB, WOUT, M, D, D}; pg8::StaticOrder S; S.init(M, D, G, bx); pg8::EpiResid<true, false> E{XR, XR, MOD + 5 * D, RSO}; pg8::gemm_phase<pg8::EpiResid<true, false>, pg8::StaticOrder, true, true>(lds, g, S, E); }
    xcd_barrier(bar);
    if constexpr (PHON(1)) norm_pass<0, true>(XR, a.in[18], MOD + 6 * D, MOD + 7 * D, H, nullptr, gw, NGW, lane);
    xcd_barrier(bar);
    if constexpr (PHON(2)) { pg8::Gemm g{H, WGU2, M, 2 * DFF, D}; pg8::StaticOrder S; S.init(M, 2 * DFF, G, bx); pg8::EpiSwiglu E{ACT}; pg8::gemm_phase<pg8::EpiSwiglu, pg8::StaticOrder, true, true>(lds, g, S, E); }
    xcd_barrier(bar);
    if constexpr (PHON(3)) { pg8::Gemm g{ACT, WD2, M, D, DFF}; pg8::StaticOrder S; S.init(M, D, G, bx); pg8::EpiResid<false, false> E{XR, XR, MOD + 8 * D, nullptr}; pg8::gemm_phase<pg8::EpiResid<false, false>, pg8::StaticOrder, true, true>(lds, g, S, E); }
    xcd_barrier(bar);
    if constexpr (PHON(1)) norm_pass<1, true>(XR, a.in[21], nullptr, nullptr, nullptr, a.out, gw, NGW, lane);
}

extern "C" void kernel_launch(void* const* d_in, const int* in_sizes, int n_in, void* d_out, int out_size, void* d_ws, size_t ws_size, hipStream_t stream) {
    static int grid_blocks = 0;
    if (grid_blocks == 0) {
        if (n_in != 22 || out_size != M * D || ws_size < WS_END) { fprintf(stderr, "kernel_launch: unexpected shapes (n_in %d, out %d, ws %zu)\n", n_in, out_size, ws_size); grid_blocks = -1; return; }
        int dev = 0, cus = 0, per_cu = 0;
        hipGetDevice(&dev);
        hipDeviceGetAttribute(&cus, hipDeviceAttributeMultiprocessorCount, dev);
        if (hipFuncSetAttribute((const void*)fwd_megakernel, hipFuncAttributeMaxDynamicSharedMemorySize, LDS_BYTES) != hipSuccess) { fprintf(stderr, "kernel_launch: hipFuncSetAttribute failed\n"); grid_blocks = -1; return; }
        if (hipOccupancyMaxActiveBlocksPerMultiprocessor(&per_cu, (const void*)fwd_megakernel, 512, LDS_BYTES) != hipSuccess || per_cu < 1) { fprintf(stderr, "kernel_launch: occupancy query gave %d\n", per_cu); per_cu = 1; }
        (void)hipGetLastError();
        grid_blocks = cus * per_cu;
    }
    if (grid_blocks < 0) return;
    hipMemsetAsync((char*)d_ws + WS_MOD, 0, MOD_ZERO_BYTES, stream);
    Args a{};
    for (int i = 0; i < 22; ++i) a.in[i] = (const float*)d_in[i];
    a.out = (float*)d_out; a.ws = (unsigned char*)d_ws;
    void* args[] = {&a};
    hipError_t e = hipLaunchCooperativeKernel((const void*)fwd_megakernel, dim3(grid_blocks), dim3(512), args, LDS_BYTES, stream);
    if (e != hipSuccess) fprintf(stderr, "cooperative launch failed: %s (grid %d)\n", hipGetErrorString(e), grid_blocks);
}
```

```cpp
#include <hip/hip_runtime.h>
#include <hip/hip_cooperative_groups.h>
#include <cstdio>
#include <cstdint>
namespace cg = cooperative_groups;

namespace pg8 {
#define PG8_LAS __attribute__((address_space(3)))
typedef unsigned short bf16_t;
typedef short bf16x8 __attribute__((ext_vector_type(8)));
typedef float f32x4 __attribute__((ext_vector_type(4)));
typedef unsigned u32x4 __attribute__((ext_vector_type(4)));
constexpr int BM = 256, BK = 64, HALF = 128, HTB = HALF * BK * 2  , STAGE_BYTES = 8 * HTB, NXCD = 8, WGM = 8;

__host__ __device__ __forceinline__ int lds_byte(int r, int c) { const int st = (r >> 4) * 2 + (c >> 5), rr = r & 15, cc = c & 31, ob = rr * 64 + cc * 2; return st * 1024 + (ob ^ (((ob >> 9) & 1) << 5)); }
__host__ __device__ __forceinline__ void stage_rc(int b, int& R, int& C) { const int st = b / 1024, sb = b % 1024, swz = sb ^ (((sb >> 9) & 1) << 5); R = (st >> 1) * 16 + swz / 64; C = (st & 1) * 32 + (swz % 64) / 2; }
__host__ __device__ __forceinline__ int perm32(int rho) { const int n = rho >> 4, i = rho & 15; return 8 * (i >> 2) + 4 * n + (i & 3); }

struct Unit { int pm, pn; };
struct Gemm { const bf16_t* A; const bf16_t* Bt; int M, N, K; };

struct StaticOrder {
    int nM, nN, nwg, G, c;
    __host__ __device__ void init(int M, int N, int G_, int c_) { nM = M / BM; nN = N / BM; nwg = nM * nN; G = G_; c = c_; }
    __host__ __device__ bool next(int i, Unit& u) const {
        const long L = (long)i * G + c; if (L >= nwg) return false;
        int wgid = (int)L; { const int q = nwg / NXCD, r = nwg % NXCD, xcd = wgid % NXCD, off = wgid / NXCD; wgid = (xcd < r ? xcd * (q + 1) : r * (q + 1) + (xcd - r) * q) + off; }
        const int nig = WGM * nN, gid = wgid / nig, fm = gid * WGM, gsz = (nM - fm) < WGM ? (nM - fm) : WGM;
        u.pm = fm + ((wgid % nig) % gsz); u.pn = (wgid % nig) / gsz; return true;
    }
    __device__ __forceinline__ void a_ready(const Unit&) const {}
    __device__ __forceinline__ void done(const Unit&) const {}
};

typedef float f32x2c_t __attribute__((ext_vector_type(2))); typedef __bf16 bf16x2c_t __attribute__((ext_vector_type(2)));
__device__ __forceinline__ unsigned cvt_pk_bf16(float lo, float hi) { f32x2c_t v = {lo, hi}; bf16x2c_t b = __builtin_convertvector(v, bf16x2c_t); return __builtin_bit_cast(unsigned, b); }
typedef unsigned u32x2 __attribute__((ext_vector_type(2)));
constexpr int MTOK = 32768, SEQL = 4096, NMODC = 9216;
constexpr float NEPS = 1e-6f;
constexpr float C2M = 0.10206207261596577f * 1.4426950408889634f;
constexpr float C2G = 0.125f * 1.4426950408889634f;
__device__ __forceinline__ unsigned short bf1(float v) { return (unsigned short)(cvt_pk_bf16(v, 0.f) & 0xffffu); }
typedef float f32x2s __attribute__((ext_vector_type(2)));
__device__ __forceinline__ unsigned swi2(float a0, float a1, float b0, float b1) {
    const f32x2s a = {a0, a1}, b = {b0, b1};
    f32x2s e; e.x = __builtin_amdgcn_exp2f(-a.x); e.y = __builtin_amdgcn_exp2f(-a.y);
    const f32x2s d = e + 1.0f; f32x2s r; r.x = __builtin_amdgcn_rcpf(d.x); r.y = __builtin_amdgcn_rcpf(d.y);
    const f32x2s o = (a * b) * r;
    return cvt_pk_bf16(o.x, o.y);
}
__device__ __forceinline__ float dot4(f32x4 v) { return (v[0] * v[0] + v[1] * v[1]) + (v[2] * v[2] + v[3] * v[3]); }
__device__ __forceinline__ float quad_sum(float s) { s += __shfl_xor(s, 16); s += __shfl_xor(s, 32); return s; }
__device__ __forceinline__ void st4(bf16_t* p, f32x4 v) { u32x2 w; w.x = cvt_pk_bf16(v[0], v[1]); w.y = cvt_pk_bf16(v[2], v[3]); *(u32x2*)p = w; }

struct EpiSwiglu {
    static constexpr bool PERM = true, AFTER_DRAIN = false; static constexpr int MIDT = -1;
    bf16_t* O;
    __device__ __forceinline__ void mid(f32x4 (&)[2][2][4][2], const Unit&, int, int) const {}
    __device__ __forceinline__ void operator()(const f32x4 (&acc)[2][2][4][2], const Unit& u, int wr, int wc, int fr, int fq) const {
        asm volatile("" : "+v"(fr), "+v"(fq));
        const int row0 = u.pm * BM + wr * 64 + fr, col0 = u.pn * 128 + wc * 32 + 8 * fq;
#pragma unroll
        for (int ai = 0; ai < 2; ++ai)
#pragma unroll
            for (int m = 0; m < 4; ++m) {
                bf16_t* rowp = O + (size_t)(row0 + ai * HALF + m * 16) * 2816 + col0;
                const f32x4 a0 = acc[ai][0][m][0], a1 = acc[ai][0][m][1], b0 = acc[ai][1][m][0], b1 = acc[ai][1][m][1];
                u32x4 w;
                w.x = swi2(a0[0], a0[1], b0[0], b0[1]); w.y = swi2(a0[2], a0[3], b0[2], b0[3]);
                w.z = swi2(a1[0], a1[1], b1[0], b1[1]); w.w = swi2(a1[2], a1[3], b1[2], b1[3]);
                *(u32x4*)rowp = w;
            }
    }
};
__device__ __forceinline__ f32x4 bf4_lo(u32x4 w) { return (f32x4){__uint_as_float(w.x << 16), __uint_as_float(w.x & 0xffff0000u), __uint_as_float(w.y << 16), __uint_as_float(w.y & 0xffff0000u)}; }
__device__ __forceinline__ f32x4 bf4_hi(u32x4 w) { return (f32x4){__uint_as_float(w.z << 16), __uint_as_float(w.z & 0xffff0000u), __uint_as_float(w.w << 16), __uint_as_float(w.w & 0xffff0000u)}; }
template <bool MIX, bool XF32> struct EpiResid {
    static constexpr bool PERM = true, AFTER_DRAIN = false; static constexpr int MIDT = MIX ? 8 : -1;
    const void* xin; bf16_t* xout; const float* gate; const float* rs2;
    __device__ __forceinline__ void mid(f32x4 (&acc)[2][2][4][2], const Unit& u, int wr, int fr) const {
        if constexpr (MIX) {
#pragma unroll
            for (int ai = 0; ai < 2; ++ai)
#pragma unroll
                for (int m = 0; m < 4; ++m) { const int row = u.pm * BM + wr * 64 + fr + ai * HALF + m * 16; const f32x4 sq = *(const f32x4*)(rs2 + 4 * row); const float q = sqrtf(((sq[2] + sq[3]) * (1.f / 512.f) + NEPS) / ((sq[0] + sq[1]) * (1.f / 512.f) + NEPS));
#pragma unroll
                    for (int bj = 0; bj < 2; ++bj)
#pragma unroll
                        for (int n = 0; n < 2; ++n) acc[ai][bj][m][n] *= q; }
        }
    }
    __device__ __forceinline__ void operator()(const f32x4 (&acc)[2][2][4][2], const Unit& u, int wr, int wc, int fr, int fq) const {
        asm volatile("" : "+v"(fr), "+v"(fq));
        const int row0 = u.pm * BM + wr * 64 + fr, col0 = u.pn * BM + wc * 32 + 8 * fq, b = u.pm >> 4;
        f32x4 gv[2][2];
#pragma unroll
        for (int bj = 0; bj < 2; ++bj)
#pragma unroll
            for (int n = 0; n < 2; ++n) gv[bj][n] = *(const f32x4*)(gate + (size_t)b * NMODC + col0 + bj * HALF + n * 4) * (MIX ? 1.0f : 0.5f);
#pragma unroll
        for (int ai = 0; ai < 2; ++ai)
#pragma unroll
            for (int m = 0; m < 4; ++m) { const int row = row0 + ai * HALF + m * 16; const size_t off = (size_t)row * 1024 + col0; float rs = 1.f; if constexpr (MIX) { const float* sp = rs2 + 4 * row + 2; rs = 1.0f / sqrtf((sp[0] + sp[1]) * (1.f / 512.f) + NEPS); }
#pragma unroll
                for (int bj = 0; bj < 2; ++bj) { f32x4 x0, x1;
                    if constexpr (XF32) { x0 = *(const f32x4*)((const float*)xin + off + bj * HALF); x1 = *(const f32x4*)((const float*)xin + off + bj * HALF + 4); }
                    else { const u32x4 w = *(const u32x4*)((const bf16_t*)xin + off + bj * HALF); x0 = bf4_lo(w); x1 = bf4_hi(w); }
                    const f32x4 o0 = x0 + gv[bj][0] * (acc[ai][bj][m][0] * rs), o1 = x1 + gv[bj][1] * (acc[ai][bj][m][1] * rs);
                    u32x4 w; w.x = cvt_pk_bf16(o0[0], o0[1]); w.y = cvt_pk_bf16(o0[2], o0[3]); w.z = cvt_pk_bf16(o1[0], o1[1]); w.w = cvt_pk_bf16(o1[2], o1[3]);
                    *(u32x4*)(xout + off + bj * HALF) = w; } }
    }
};
__device__ __forceinline__ void rope4(f32x4 x1, f32x4 x2, const float* cs, f32x4& y1, f32x4& y2) {
    const f32x4 t0 = *(const f32x4*)cs, t1 = *(const f32x4*)(cs + 4);
    const f32x4 c = {t0[0], t0[2], t1[0], t1[2]}, s = {t0[1], t0[3], t1[1], t1[3]};
    y1 = x1 * c - x2 * s; y2 = x1 * s + x2 * c;
}
struct EpiWin {
    static constexpr bool PERM = false, AFTER_DRAIN = false; static constexpr int MIDT = -1;
    bf16_t *ZQ, *ZKV, *KPE, *QG, *KG, *VTG; float *SSQQ, *SSQKV; const float *gq, *gk, *ropeM, *ropeG;
    __device__ __forceinline__ void mid(f32x4 (&)[2][2][4][2], const Unit&, int, int) const {}
    __device__ __forceinline__ void operator()(const f32x4 (&acc)[2][2][4][2], const Unit& u, int wr, int wc, int fr, int fq) const {
        asm volatile("" : "+v"(fr), "+v"(fq));
        const int row0 = u.pm * BM + wr * 64 + fr;
        if (u.pn == 0) {
#pragma unroll
            for (int ai = 0; ai < 2; ++ai)
#pragma unroll
                for (int m = 0; m < 4; ++m) { const int row = row0 + ai * HALF + m * 16; float s = 0.f;
#pragma unroll
                    for (int bj = 0; bj < 2; ++bj)
#pragma unroll
                        for (int n = 0; n < 2; ++n) { const f32x4 v = acc[ai][bj][m][n]; s += dot4(v); st4(ZQ + (size_t)row * 256 + bj * HALF + wc * 32 + n * 16 + 4 * fq, v); }
                    s = quad_sum(s); if (fq == 0) SSQQ[row * 4 + wc] = s; }
        } else if (u.pn <= 2 || (u.pn == 3 && wc < 2)) {
            const bool isq = u.pn <= 2; const float* g = isq ? gq : gk;
            bf16_t* dst = isq ? QG + (4 * (u.pn - 1) + wc) * 64 : KG + wc * 64; const int pitch = isq ? 512 : 128; const float osc = isq ? C2G : 1.f;
            f32x4 gv[2][2];
#pragma unroll
            for (int bj = 0; bj < 2; ++bj)
#pragma unroll
                for (int n = 0; n < 2; ++n) gv[bj][n] = *(const f32x4*)(g + 32 * bj + 16 * n + 4 * fq) * osc;
#pragma unroll
            for (int ai = 0; ai < 2; ++ai)
#pragma unroll
                for (int m = 0; m < 4; ++m) { const int row = row0 + ai * HALF + m * 16; float s = 0.f;
#pragma unroll
                    for (int bj = 0; bj < 2; ++bj)
#pragma unroll
                        for (int n = 0; n < 2; ++n) s += dot4(acc[ai][bj][m][n]);
                    s = quad_sum(s); const float rstd = 1.0f / sqrtf(s * (1.f / 64.f) + NEPS);
                    const int srow = row & (SEQL - 1), prow = srow >> 6, pcol = srow & 63;
#pragma unroll
                    for (int bj = 0; bj < 2; ++bj) { const int pos = bj ? pcol : prow; f32x4 y1, y2;
                        rope4(acc[ai][bj][m][0] * rstd * gv[bj][0], acc[ai][bj][m][1] * rstd * gv[bj][1], ropeG + (pos * 16 + 4 * fq) * 2, y1, y2);
                        bf16_t* dp = isq ? dst + (size_t)row * pitch : KG + ((((size_t)((row >> 12) * 2 + wc) * 64 + (srow >> 6)) * 64 + (srow & 63)) * 64);
                        st4(dp + 32 * bj + 4 * fq, y1); st4(dp + 32 * bj + 16 + 4 * fq, y2); } }
        } else if (u.pn == 3) {
            const int hk = wc - 2;
#pragma unroll
            for (int ai = 0; ai < 2; ++ai)
#pragma unroll
                for (int m = 0; m < 4; ++m) { const int row = row0 + ai * HALF + m * 16;
#pragma unroll
                    for (int bj = 0; bj < 2; ++bj)
#pragma unroll
                        for (int n = 0; n < 2; ++n)
#pragma unroll
                            for (int i = 0; i < 4; ++i) VTG[((((size_t)((row >> 12) * 2 + hk) * 64 + ((row & (SEQL - 1)) >> 6)) * 64 + (32 * bj + 16 * n + 4 * fq + i)) * 64) + (row & 63)] = bf1(acc[ai][bj][m][n][i]); }
        } else {
#pragma unroll
            for (int ai = 0; ai < 2; ++ai)
#pragma unroll
                for (int m = 0; m < 4; ++m) { const int row = row0 + ai * HALF + m * 16; float s = 0.f;
#pragma unroll
                    for (int n = 0; n < 2; ++n) { const f32x4 v = acc[ai][0][m][n]; s += dot4(v); st4(ZKV + (size_t)row * 128 + wc * 32 + n * 16 + 4 * fq, v); }
                    s = quad_sum(s); if (fq == 0) SSQKV[row * 4 + wc] = s;
                    if (wc == 0) { const int srow = row & (SEQL - 1), prow = srow >> 6, pcol = srow & 63; const int a = fq >> 1, e0 = 4 * (fq & 1), pos = a ? pcol : prow; f32x4 y1, y2;
                        rope4(acc[ai][1][m][0], acc[ai][1][m][1], ropeM + (pos * 8 + e0) * 2, y1, y2);
                        st4(KPE + (size_t)row * 32 + 16 * a + e0, y1); st4(KPE + (size_t)row * 32 + 16 * a + 8 + e0, y2); } }
        }
    }
};
struct EpiUq {
    static constexpr bool PERM = false, AFTER_DRAIN = false; static constexpr int MIDT = -1;
    bf16_t* QM; const float* SSQQ; const float* ropeM;
    __device__ __forceinline__ void mid(f32x4 (&)[2][2][4][2], const Unit&, int, int) const {}
    __device__ __forceinline__ void operator()(const f32x4 (&acc)[2][2][4][2], const Unit& u, int wr, int wc, int fr, int fq) const {
        asm volatile("" : "+v"(fr), "+v"(fq));
        const int row0 = u.pm * BM + wr * 64 + fr;
#pragma unroll
        for (int ai = 0; ai < 2; ++ai)
#pragma unroll
            for (int m = 0; m < 4; ++m) { const int row = row0 + ai * HALF + m * 16; const f32x4 sq = *(const f32x4*)(SSQQ + row * 4);
                const float sc = C2M / sqrtf(((sq[0] + sq[1]) + (sq[2] + sq[3])) * (1.f / 256.f) + NEPS);
                bf16_t* qrow = QM + (size_t)row * 768;
                if (u.pn < 2) {
#pragma unroll
                    for (int bj = 0; bj < 2; ++bj)
#pragma unroll
                        for (int n = 0; n < 2; ++n) { const int c = u.pn * BM + bj * HALF + wc * 32 + n * 16 + 4 * fq; st4(qrow + (c >> 6) * 96 + (c & 63), acc[ai][bj][m][n] * sc); }
                } else {
                    const int srow = row & (SEQL - 1), prow = srow >> 6, pcol = srow & 63; const int a = fq >> 1, e0 = 4 * (fq & 1), pos = a ? pcol : prow;
#pragma unroll
                    for (int bj = 0; bj < 2; ++bj) { f32x4 y1, y2; rope4(acc[ai][bj][m][0] * sc, acc[ai][bj][m][1] * sc, ropeM + (pos * 8 + e0) * 2, y1, y2);
                        bf16_t* hp = qrow + (4 * bj + wc) * 96 + 64; st4(hp + 16 * a + e0, y1); st4(hp + 16 * a + 8 + e0, y2); }
                } }
    }
};
struct EpiUkv {
    static constexpr bool PERM = false, AFTER_DRAIN = false; static constexpr int MIDT = -1;
    bf16_t *KN, *VTM; const float* SSQKV;
    __device__ __forceinline__ void mid(f32x4 (&)[2][2][4][2], const Unit&, int, int) const {}
    __device__ __forceinline__ void operator()(const f32x4 (&acc)[2][2][4][2], const Unit& u, int wr, int wc, int fr, int fq) const {
        asm volatile("" : "+v"(fr), "+v"(fq));
        const int row0 = u.pm * BM + wr * 64 + fr;
#pragma unroll
        for (int ai = 0; ai < 2; ++ai)
#pragma unroll
            for (int m = 0; m < 4; ++m) { const int row = row0 + ai * HALF + m * 16; const f32x4 sq = *(const f32x4*)(SSQKV + row * 4);
                const float sc = 1.0f / sqrtf(((sq[0] + sq[1]) + (sq[2] + sq[3])) * (1.f / 128.f) + NEPS);
                if (u.pn < 2) {
#pragma unroll
                    for (int bj = 0; bj < 2; ++bj)
#pragma unroll
                        for (int n = 0; n < 2; ++n) { const int c = u.pn * BM + bj * HALF + wc * 32 + n * 16 + 4 * fq; st4(KN + ((((size_t)((row >> 12) * 8 + (c >> 6)) * 64 + ((row & (SEQL - 1)) >> 6)) * 64 + (row & 63)) * 64) + (c & 63), acc[ai][bj][m][n] * sc); }
                } else {
#pragma unroll
                    for (int bj = 0; bj < 2; ++bj)
#pragma unroll
                        for (int n = 0; n < 2; ++n)
#pragma unroll
                            for (int i = 0; i < 4; ++i) { const int c = (u.pn - 2) * BM + bj * HALF + wc * 32 + n * 16 + 4 * fq + i; VTM[((((size_t)((row >> 12) * 8 + (c >> 6)) * 64 + ((row & (SEQL - 1)) >> 6)) * 64 + (c & 63)) * 64) + (row & 63)] = bf1(acc[ai][bj][m][n][i] * sc); }
                } }
    }
};
template <class Epi, class Sched, bool ALIGN_EPI = false, bool SP2 = false>
__device__ __forceinline__ void gemm_phase(PG8_LAS unsigned char* lds, const Gemm g, const Sched S, const Epi E) {
    int tid_ = threadIdx.x; asm volatile("" : "+v"(tid_));
    const int tid = tid_, wid = __builtin_amdgcn_readfirstlane(tid >> 6), lane = tid & 63, wr = wid >> 2, wc = wid & 3, fr = lane & 15, fq = lane >> 4;
    const int K = g.K, nt = K / BK;
    unsigned voffA[2], voffB[2];
#pragma unroll
    for (int i = 0; i < 2; ++i) { int R, C; stage_rc(tid * 16 + i * 8192, R, C); const int Rb = Epi::PERM ? ((R & ~31) + perm32(R & 31)) : R;
        voffA[i] = (unsigned)(R * K + C) * 2u; voffB[i] = (unsigned)(Rb * K + C) * 2u; }
    const size_t kstep = (size_t)(BK * 2);
    const size_t hstep = (size_t)HALF * K * 2;
    const size_t tstep = 2 * hstep;
    const unsigned ldsw = (unsigned)wid * 1024u;
    const int aoff = lds_byte(wr * 64 + fr, fq * 8), boff = lds_byte(wc * 32 + fr, fq * 8);
#define PG8_SA(b, h) (((b) * 2 + (h)) * HTB)
#define PG8_SB(b, h) ((4 + (b) * 2 + (h)) * HTB)
#define PG8_STAGE(bufoff, gbase, voff) do { _Pragma("unroll") for (int _i = 0; _i < 2; ++_i) \
        __builtin_amdgcn_global_load_lds((const unsigned*)((const char*)(gbase) + (voff)[_i]), (PG8_LAS unsigned*)(lds + (bufoff) + ldsw + _i * 8192), 16, 0, 0); } while (0)
#define PG8_LDA(dst, b, h) do { _Pragma("unroll") for (int m = 0; m < 4; ++m) _Pragma("unroll") for (int k = 0; k < 2; ++k) dst[m][k] = *(const PG8_LAS bf16x8*)(lds + PG8_SA(b, h) + aoff + m * 2048 + k * 1024); } while (0)
#define PG8_LDB(dst, b, h) do { _Pragma("unroll") for (int n = 0; n < 2; ++n) _Pragma("unroll") for (int k = 0; k < 2; ++k) dst[n][k] = *(const PG8_LAS bf16x8*)(lds + PG8_SB(b, h) + boff + n * 2048 + k * 1024); } while (0)
#define PG8_MMA(ai, bj, At, Bt) do { __builtin_amdgcn_s_setprio(1); _Pragma("unroll") for (int m = 0; m < 4; ++m) _Pragma("unroll") for (int n = 0; n < 2; ++n) _Pragma("unroll") for (int k = 0; k < 2; ++k) \
        acc[ai][bj][m][n] = __builtin_amdgcn_mfma_f32_16x16x32_bf16(Bt[n][k], At[m][k], acc[ai][bj][m][n], 0, 0, 0); __builtin_amdgcn_s_setprio(0); } while (0)
#define PG8_WAIT_V(n) asm volatile("s_waitcnt vmcnt(" #n ")" ::: "memory")
#define PG8_WAIT_L(n) asm volatile("s_waitcnt lgkmcnt(" #n ")" ::: "memory")
#define PG8_BAR __builtin_amdgcn_s_barrier()
#define PG8_SCHED __builtin_amdgcn_sched_barrier(0)
    Unit cur, nxt; int ui = 0;
    if (!S.next(0, cur)) return;
    f32x4 acc[2][2][4][2];
#pragma unroll
    for (int a = 0; a < 2; ++a)
#pragma unroll
        for (int b = 0; b < 2; ++b)
#pragma unroll
            for (int m = 0; m < 4; ++m)
#pragma unroll
                for (int n = 0; n < 2; ++n) acc[a][b][m][n] = (f32x4){0.f, 0.f, 0.f, 0.f};
    bf16x8 At[4][2], B0[2][2], B1[2][2];
    const char* cA = (const char*)g.A + (size_t)cur.pm * tstep; const char* cB = (const char*)g.Bt + (size_t)cur.pn * tstep;
    S.a_ready(cur);
    if constexpr (SP2) {
        PG8_STAGE(PG8_SB(0, 0), cB, voffB); PG8_STAGE(PG8_SB(0, 1), cB + hstep, voffB); PG8_STAGE(PG8_SA(0, 0), cA, voffA); PG8_STAGE(PG8_SA(0, 1), cA + hstep, voffA);
        if (wr == 1) PG8_BAR;
        PG8_WAIT_V(2); PG8_BAR;
        PG8_STAGE(PG8_SB(1, 0), cB + kstep, voffB); PG8_STAGE(PG8_SA(1, 0), cA + kstep, voffA); PG8_STAGE(PG8_SB(1, 1), cB + hstep + kstep, voffB);
        PG8_WAIT_V(6); PG8_BAR;
    } else {
        PG8_STAGE(PG8_SB(0, 0), cB, voffB); PG8_STAGE(PG8_SA(0, 0), cA, voffA); PG8_STAGE(PG8_SB(0, 1), cB + hstep, voffB); PG8_STAGE(PG8_SA(0, 1), cA + hstep, voffA);
        if (wr == 1) PG8_BAR;
        PG8_WAIT_V(4); PG8_BAR;
        PG8_STAGE(PG8_SB(1, 0), cB + kstep, voffB); PG8_STAGE(PG8_SA(1, 0), cA + kstep, voffA); PG8_STAGE(PG8_SB(1, 1), cB + hstep + kstep, voffB);
        PG8_WAIT_V(6); PG8_BAR;
    }
    for (;;) {
        const bool has_next = S.next(ui + 1, nxt);
        const char* nA = has_next ? (const char*)g.A + (size_t)nxt.pm * tstep : cA; const char* nB = has_next ? (const char*)g.Bt + (size_t)nxt.pn * tstep : cB;
        for (int t = 0; t < nt; t += 2) {
            if constexpr (Epi::MIDT >= 0) { if (t == Epi::MIDT) E.mid(acc, cur, wr, fr); }
            const bool last = (t == nt - 2);
            const char* a1 = cA + (size_t)(t + 1) * kstep;
            const char* a2 = last ? nA : cA + (size_t)(t + 2) * kstep; const char* b2 = last ? nB : cB + (size_t)(t + 2) * kstep;
            const char* a3 = a2 + kstep; const char* b3 = b2 + kstep;
            if (last && has_next) S.a_ready(nxt);
            if constexpr (SP2) {
            PG8_LDB(B0, 0, 0); PG8_LDB(B1, 0, 1); PG8_SCHED; PG8_LDA(At, 0, 0); PG8_STAGE(PG8_SA(1, 1), a1 + hstep, voffA);
            PG8_WAIT_V(8); PG8_WAIT_L(0); PG8_BAR; PG8_MMA(0, 0, At, B0); PG8_MMA(0, 1, At, B1); PG8_BAR; PG8_SCHED;
            PG8_LDA(At, 0, 1); PG8_STAGE(PG8_SB(0, 0), b2, voffB); PG8_STAGE(PG8_SB(0, 1), b2 + hstep, voffB); PG8_STAGE(PG8_SA(0, 0), a2, voffA);
            PG8_WAIT_V(8); PG8_WAIT_L(0); PG8_BAR; PG8_MMA(1, 0, At, B0); PG8_MMA(1, 1, At, B1); PG8_BAR; PG8_SCHED;
            PG8_LDB(B0, 1, 0); PG8_LDB(B1, 1, 1); PG8_SCHED; PG8_LDA(At, 1, 0); PG8_STAGE(PG8_SA(0, 1), a2 + hstep, voffA);
            PG8_WAIT_V(8); PG8_WAIT_L(0); PG8_BAR; PG8_MMA(0, 0, At, B0); PG8_MMA(0, 1, At, B1); PG8_BAR; PG8_SCHED;
            PG8_LDA(At, 1, 1); PG8_STAGE(PG8_SB(1, 0), b3, voffB); PG8_STAGE(PG8_SB(1, 1), b3 + hstep, voffB); PG8_STAGE(PG8_SA(1, 0), a3, voffA);
            PG8_WAIT_V(8); PG8_WAIT_L(0); PG8_BAR; PG8_MMA(1, 0, At, B0); PG8_MMA(1, 1, At, B1); PG8_BAR; PG8_SCHED;
            } else {
            PG8_LDB(B0, 0, 0); PG8_SCHED; PG8_LDA(At, 0, 0); PG8_STAGE(PG8_SA(1, 1), a1 + hstep, voffA);
            PG8_WAIT_L(8); PG8_BAR; PG8_WAIT_L(0); PG8_MMA(0, 0, At, B0); PG8_BAR; PG8_SCHED;
            PG8_LDB(B1, 0, 1); PG8_STAGE(PG8_SB(0, 0), b2, voffB);
            PG8_BAR; PG8_WAIT_L(0); PG8_MMA(0, 1, At, B1); PG8_BAR;
            PG8_LDA(At, 0, 1); PG8_STAGE(PG8_SA(0, 0), a2, voffA);
            PG8_BAR; PG8_WAIT_L(0); PG8_MMA(1, 0, At, B0); PG8_BAR; PG8_SCHED;
            PG8_STAGE(PG8_SB(0, 1), b2 + hstep, voffB);
            PG8_WAIT_V(6); PG8_BAR; PG8_MMA(1, 1, At, B1); PG8_BAR;
            PG8_LDB(B0, 1, 0); PG8_SCHED; PG8_LDA(At, 1, 0); PG8_STAGE(PG8_SA(0, 1), a2 + hstep, voffA);
            PG8_WAIT_L(8); PG8_BAR; PG8_WAIT_L(0); PG8_MMA(0, 0, At, B0); PG8_BAR; PG8_SCHED;
            PG8_LDB(B1, 1, 1); PG8_STAGE(PG8_SB(1, 0), b3, voffB);
            PG8_BAR; PG8_WAIT_L(0); PG8_MMA(0, 1, At, B1); PG8_BAR;
            PG8_LDA(At, 1, 1); PG8_STAGE(PG8_SA(1, 0), a3, voffA);
            PG8_BAR; PG8_WAIT_L(0); PG8_MMA(1, 0, At, B0); PG8_BAR; PG8_SCHED;
            PG8_STAGE(PG8_SB(1, 1), b3 + hstep, voffB);
            PG8_WAIT_V(6); PG8_BAR; PG8_MMA(1, 1, At, B1); PG8_BAR;
            }
        }
        if constexpr (ALIGN_EPI) { if (wr == 0) PG8_BAR; }
        if constexpr (!Epi::AFTER_DRAIN) { E(acc, cur, wr, wc, fr, fq); S.done(cur); }
        if (!has_next) break;
#pragma unroll
        for (int a = 0; a < 2; ++a)
#pragma unroll
            for (int b = 0; b < 2; ++b)
#pragma unroll
                for (int m = 0; m < 4; ++m)
#pragma unroll
                    for (int n = 0; n < 2; ++n) acc[a][b][m][n] = (f32x4){0.f, 0.f, 0.f, 0.f};
        cur = nxt; cA = nA; cB = nB; ++ui;
        if constexpr (ALIGN_EPI) { if (wr == 1) PG8_BAR; }
    }
    PG8_WAIT_V(0);
    if constexpr (!ALIGN_EPI) { if (wr == 0) PG8_BAR; }
    PG8_BAR;
    if constexpr (Epi::AFTER_DRAIN) { E.fused(acc, cur, wr, wc, fr, fq, lds, wid, lane); S.done(cur); }
#undef PG8_SA
#undef PG8_SB
#undef PG8_STAGE
#undef PG8_LDA
#undef PG8_LDB
#undef PG8_MMA
#undef PG8_WAIT_V
#undef PG8_WAIT_L
#undef PG8_BAR
#undef PG8_SCHED
}
}

#define LAS __attribute__((address_space(3)))
namespace att {
typedef unsigned short bf16_t;
typedef short bf16x8 __attribute__((ext_vector_type(8)));
typedef float f32x16 __attribute__((ext_vector_type(16)));
typedef float f32x4 __attribute__((ext_vector_type(4)));
typedef unsigned u32x4 __attribute__((ext_vector_type(4)));
typedef unsigned u32x2 __attribute__((ext_vector_type(2)));
constexpr int KST = 208, VST = 144, KBUF = 64 * KST, VBUF = 64 * VST;
constexpr int MTOK = 32768, SEQL = 4096;
constexpr float THR = 32.0f;
typedef float f32x2_t __attribute__((ext_vector_type(2))); typedef __bf16 bf16x2_t __attribute__((ext_vector_type(2)));
__device__ __forceinline__ unsigned cvtpk(float lo, float hi) { f32x2_t v = {lo, hi}; bf16x2_t b = __builtin_convertvector(v, bf16x2_t); return __builtin_bit_cast(unsigned, b); }
__device__ __forceinline__ float xhalf_max(float m) { auto rr = __builtin_amdgcn_permlane32_swap(__float_as_uint(m), __float_as_uint(m), false, false); return fmaxf(__uint_as_float(rr[0]), __uint_as_float(rr[1])); }
__device__ __forceinline__ float xhalf_sum(float m) { auto rr = __builtin_amdgcn_permlane32_swap(__float_as_uint(m), __float_as_uint(m), false, false); return __uint_as_float(rr[0]) + __uint_as_float(rr[1]); }
__device__ __forceinline__ float max3f(float a, float b, float c) { float r; asm("v_max3_f32 %0, %1, %2, %3" : "=v"(r) : "v"(a), "v"(b), "v"(c)); return r; }
__device__ __forceinline__ float max2f(float a, float b) { float r; asm("v_max_f32_e32 %0, %1, %2" : "=v"(r) : "v"(a), "v"(b)); return r; }
#define ATT_BAR() do { __builtin_amdgcn_sched_barrier(0); asm volatile("s_waitcnt lgkmcnt(0)\n\ts_barrier" ::: "memory"); __builtin_amdgcn_sched_barrier(0); } while (0)

template <int GRP> struct AttCtx {
    LAS unsigned char* lds; const bf16_t* Q; const bf16_t* KN; const bf16_t* KPE; const bf16_t* VT; bf16_t* O;
    const bf16_t *kl, *pl, *vl;
    size_t rowbase, qrow; int b, h0, tid, hi, kro, vro, kwo, pwo, vwo, kkey, kc, pkey, pc; bool trail;
};
template <int GRP> struct AttState {
    static constexpr int NKS = (GRP == 0 ? 96 : 64) / 16;
    bf16x8 qr[NKS]; f32x16 o0, o1; unsigned pw[16]; float mhat, lrun, ssq; int refnz;
};
template <int GRP> __device__ __forceinline__ void att_ldk(const AttCtx<GRP>& C, int step, u32x4& kreg, u32x4& preg) {
    const int h = C.h0 + (step >> 6), t = step & 63, kvh = GRP == 0 ? h : (h >> 2);
    kreg = *(const u32x4*)(C.kl + (kvh * 64 + t) * 4096);
    if (GRP == 0 && C.tid < 256) preg = *(const u32x4*)(C.pl + t * 2048);
}
template <int GRP> __device__ __forceinline__ void att_ldv(const AttCtx<GRP>& C, int step, u32x4& vreg) {
    const int h = C.h0 + (step >> 6), t = step & 63, kvh = GRP == 0 ? h : (h >> 2);
    vreg = *(const u32x4*)(C.vl + (kvh * 64 + t) * 4096);
}
template <int GRP> __device__ __forceinline__ void att_stk(const AttCtx<GRP>& C, int buf, const u32x4& kreg, const u32x4& preg) {
    *(LAS u32x4*)(C.lds + buf * KBUF + C.kwo) = kreg; if (GRP == 0 && C.tid < 256) *(LAS u32x4*)(C.lds + buf * KBUF + C.pwo) = preg;
}
template <int GRP> __device__ __forceinline__ void att_stv(const AttCtx<GRP>& C, int buf, const u32x4& vreg) { *(LAS u32x4*)(C.lds + buf * VBUF + C.vwo) = vreg; }
template <int GRP> __device__ __forceinline__ void att_stld(const AttCtx<GRP>& C, int s, u32x4& kreg, u32x4& preg, u32x4& vreg) {
    constexpr int NSTEP = 256;
    if (s + 2 < NSTEP) att_stk<GRP>(C, s & 1, kreg, preg);
    if (s + 1 < NSTEP) att_stv<GRP>(C, (s + 1) & 1, vreg);
    if (s + 3 < NSTEP) att_ldk<GRP>(C, s + 3, kreg, preg);
    if (s + 2 < NSTEP) att_ldv<GRP>(C, s + 2, vreg);
}
template <int GRP, int KS0, int N> __device__ __forceinline__ void att_kfrag(const AttCtx<GRP>& C, int slot, bf16x8 (&kf)[2 * N]) {
    const LAS unsigned char* kb = C.lds + slot * KBUF + C.kro;
#pragma unroll
    for (int i = 0; i < N; ++i) { kf[2 * i] = *(const LAS bf16x8*)(kb + (KS0 + i) * 32); kf[2 * i + 1] = *(const LAS bf16x8*)(kb + 32 * KST + (KS0 + i) * 32); }
}
template <int GRP> __device__ __forceinline__ void att_vfrag(const AttCtx<GRP>& C, int buf, bf16x8 (&vf)[8]) {
    const LAS unsigned char* vb = C.lds + buf * VBUF + C.vro;
#pragma unroll
    for (int ks = 0; ks < 4; ++ks) { vf[2 * ks] = *(const LAS bf16x8*)(vb + ks * 32); vf[2 * ks + 1] = *(const LAS bf16x8*)(vb + 32 * VST + ks * 32); }
}
template <int GRP> __device__ __forceinline__ void att_pv(AttState<GRP>& S, const bf16x8 (&vf)[8]) {
#pragma unroll
    for (int ks = 0; ks < 4; ++ks) { const u32x4 w = {S.pw[4 * ks], S.pw[4 * ks + 1], S.pw[4 * ks + 2], S.pw[4 * ks + 3]}; const bf16x8 pb = __builtin_bit_cast(bf16x8, w);
        S.o0 = __builtin_amdgcn_mfma_f32_32x32x16_bf16(vf[2 * ks], pb, S.o0, 0, 0, 0); S.o1 = __builtin_amdgcn_mfma_f32_32x32x16_bf16(vf[2 * ks + 1], pb, S.o1, 0, 0, 0); }
}
template <int GRP> __device__ __forceinline__ void att_finish_head(const AttCtx<GRP>& C, AttState<GRP>& S, int h) {
    const float inv = 1.0f / xhalf_sum(S.lrun);
    bf16_t* orow = C.O + C.qrow * 1024 + GRP * 512 + h * 64 + 4 * C.hi;
#pragma unroll
    for (int rr = 0; rr < 4; ++rr) {
        const f32x4 v0 = (f32x4){S.o0[4 * rr], S.o0[4 * rr + 1], S.o0[4 * rr + 2], S.o0[4 * rr + 3]} * inv, v1 = (f32x4){S.o1[4 * rr], S.o1[4 * rr + 1], S.o1[4 * rr + 2], S.o1[4 * rr + 3]} * inv;
        S.ssq += (v0[0] * v0[0] + v0[1] * v0[1]) + (v0[2] * v0[2] + v0[3] * v0[3]) + (v1[0] * v1[0] + v1[1] * v1[1]) + (v1[2] * v1[2] + v1[3] * v1[3]);
        u32x2 s0, s1; s0.x = cvtpk(v0[0], v0[1]); s0.y = cvtpk(v0[2], v0[3]); s1.x = cvtpk(v1[0], v1[1]); s1.y = cvtpk(v1[2], v1[3]);
        *(u32x2*)(orow + 8 * rr) = s0; *(u32x2*)(orow + 32 + 8 * rr) = s1;
    }
}
template <int GRP, bool has_next> __device__ __forceinline__ void att_step(const AttCtx<GRP>& C, AttState<GRP>& S, int s, f32x16& P0, f32x16& P1, f32x16& PN0, f32x16& PN1, u32x4& kreg, u32x4& preg, u32x4& vreg) {
    constexpr int DK = GRP == 0 ? 96 : 64, NKS = DK / 16, QP = GRP == 0 ? 768 : 512, NSTEP = 256, NK0 = NKS / 2, NK1 = NKS - NK0;
    const int h = C.h0 + (s >> 6), t = s & 63;
    bf16x8 kfa[2 * NK0], kfb[2 * NK1], vf[8];
    if (has_next) {
        if (t == 63) {
#pragma unroll
            for (int ks = 0; ks < NKS; ++ks) S.qr[ks] = *(const bf16x8*)(C.Q + C.qrow * QP + (h + 1) * DK + ks * 16 + C.hi * 8);
        }
        att_kfrag<GRP, 0, NK0>(C, (s + 1) & 1, kfa);
    }
    if (has_next) { PN0 = __builtin_amdgcn_mfma_f32_32x32x16_bf16(kfa[0], S.qr[0], (f32x16){}, 0, 0, 0); PN1 = __builtin_amdgcn_mfma_f32_32x32x16_bf16(kfa[1], S.qr[0], (f32x16){}, 0, 0, 0); }
    if ((t & 7) == 0) {
        float ma = max3f(P0[0], P0[1], P0[2]), mb = max3f(P0[3], P0[4], P0[5]), mc = max3f(P1[0], P1[1], P1[2]), md = max3f(P1[3], P1[4], P1[5]);
        ma = max3f(ma, P0[6], P0[7]); mb = max3f(mb, P0[8], P0[9]); mc = max3f(mc, P1[6], P1[7]); md = max3f(md, P1[8], P1[9]);
        ma = max3f(ma, P0[10], P0[11]); mb = max3f(mb, P0[12], P0[13]); mc = max3f(mc, P1[10], P1[11]); md = max3f(md, P1[12], P1[13]);
        ma = max3f(ma, P0[14], P0[15]); mc = max3f(mc, P1[14], P1[15]); ma = max3f(ma, mb, mc); mb = md;
        const float mx = xhalf_max(max2f(ma, mb));
        const int up = __any(mx > THR), dn = (t == 0) ? __any(mx < -THR) : 0;
        if (up | dn) {
            const float dl = ceilf((t == 0) ? mx : fmaxf(mx, 0.f));
            const float f = (t == 0) ? 0.f : __builtin_amdgcn_exp2f(-dl);
            S.mhat += dl; S.lrun *= f;
#pragma unroll
            for (int r = 0; r < 16; ++r) { P0[r] -= dl; P1[r] -= dl; S.o0[r] *= f; S.o1[r] *= f; }
            S.refnz = __any(S.mhat != 0.f);
        }
    }
    __builtin_amdgcn_sched_barrier(0);
    const unsigned mbits = (t == 63 || C.hi != 0) ? 0u : (__float_as_uint(-S.mhat) >> 16);
    const u32x4 qxw = {mbits, 0u, 0u, 0u}; const bf16x8 qx = __builtin_bit_cast(bf16x8, qxw);
    const bf16x8 ones = {0x3f80, 0x3f80, 0x3f80, 0x3f80, 0x3f80, 0x3f80, 0x3f80, 0x3f80};
    constexpr int NE = NKS - 1;
    float ra = 0.f, rb = 0.f, rc = 0.f, rd = 0.f;
#define ATT_SUMPACK(j) do { const float e0_ = (j) < 8 ? P0[2 * ((j) & 7)] : P1[2 * ((j) & 7)], e1_ = (j) < 8 ? P0[2 * ((j) & 7) + 1] : P1[2 * ((j) & 7) + 1]; \
        if ((j) & 1) { rc += e0_; rd += e1_; } else { ra += e0_; rb += e1_; } S.pw[j] = cvtpk(e0_, e1_); } while (0)
#pragma unroll
    for (int c = 1; c < NKS; ++c) {
        if (has_next) {
            if (c == NK0) att_kfrag<GRP, NK0, NK1>(C, (s + 1) & 1, kfb);
            const bf16x8 a0 = c < NK0 ? kfa[2 * c] : kfb[2 * (c - NK0)], a1 = c < NK0 ? kfa[2 * c + 1] : kfb[2 * (c - NK0) + 1];
            PN0 = __builtin_amdgcn_mfma_f32_32x32x16_bf16(a0, S.qr[c], PN0, 0, 0, 0); PN1 = __builtin_amdgcn_mfma_f32_32x32x16_bf16(a1, S.qr[c], PN1, 0, 0, 0);
        }
#pragma unroll
        for (int j = (c - 1) * 16 / NE; j < c * 16 / NE; ++j) {
            if (j < 8) { P0[2 * j] = __builtin_amdgcn_exp2f(P0[2 * j]); P0[2 * j + 1] = __builtin_amdgcn_exp2f(P0[2 * j + 1]); }
            else { P1[2 * (j - 8)] = __builtin_amdgcn_exp2f(P1[2 * (j - 8)]); P1[2 * (j - 8) + 1] = __builtin_amdgcn_exp2f(P1[2 * (j - 8) + 1]); }
        }
        if (c > 1) {
#pragma unroll
            for (int j = (c - 2) * 16 / NE; j < (c - 1) * 16 / NE; ++j) ATT_SUMPACK(j);
        }
        __builtin_amdgcn_sched_barrier(0);
    }
    if (has_next && S.refnz && t != 63) { PN0 = __builtin_amdgcn_mfma_f32_32x32x16_bf16(ones, qx, PN0, 0, 0, 0); PN1 = __builtin_amdgcn_mfma_f32_32x32x16_bf16(ones, qx, PN1, 0, 0, 0); }
    att_vfrag<GRP>(C, s & 1, vf);
#pragma unroll
    for (int j = (NE - 1) * 16 / NE; j < 16; ++j) ATT_SUMPACK(j);
#undef ATT_SUMPACK
    S.lrun += (ra + rb) + (rc + rd);
    att_pv<GRP>(S, vf);
    if (t == 63) {
        att_finish_head<GRP>(C, S, h);
        S.o0 = (f32x16){}; S.o1 = (f32x16){}; S.lrun = 0.f; S.mhat = 0.f; S.refnz = 0;
    }
    att_stld<GRP>(C, s, kreg, preg, vreg);
    ATT_BAR();
}
template <int GRP>
__device__ __forceinline__ void attn_unit(LAS unsigned char* lds, int b, int qb, int hh, const bf16_t* __restrict__ Q, const bf16_t* __restrict__ KN, const bf16_t* __restrict__ KPE,
                                          const bf16_t* __restrict__ VT, bf16_t* __restrict__ O, float* __restrict__ RS) {
    constexpr int DK = GRP == 0 ? 96 : 64, NKS = DK / 16, QP = GRP == 0 ? 768 : 512, NSTEP = 4 * 64;
    int tid_ = threadIdx.x; asm volatile("" : "+v"(tid_));
    const int tid = tid_, lane = tid & 63, r32 = lane & 31, hi = lane >> 5, wid = __builtin_amdgcn_readfirstlane(tid >> 6);
    AttCtx<GRP> C;
    C.b = b; C.h0 = 4 * hh; C.lds = lds; C.Q = Q; C.KN = KN; C.KPE = KPE; C.VT = VT; C.O = O; C.tid = tid; C.hi = hi; C.trail = false;
    C.rowbase = (size_t)b * SEQL; C.qrow = C.rowbase + (size_t)qb * 256 + wid * 32 + r32;
    const int pr = (r32 & 19) | ((r32 & 4) << 1) | ((r32 & 8) >> 1);
    C.kro = pr * KST + hi * 16; C.vro = 2 * KBUF + r32 * VST + hi * 16;
    C.kkey = tid >> 3; C.kc = tid & 7; C.pkey = (tid >> 2) & 63; C.pc = tid & 3;
    { constexpr int NHK = GRP == 0 ? 8 : 2; const size_t lo = (size_t)C.kkey * 64 + C.kc * 8;
      C.kl = KN + (size_t)(b * NHK) * 64 * 4096 + lo; C.vl = VT + (size_t)(b * NHK) * 64 * 4096 + lo; C.pl = KPE + (C.rowbase + C.pkey) * 32 + C.pc * 8; }
    C.kwo = C.kkey * KST + C.kc * 16; C.pwo = C.pkey * KST + 128 + C.pc * 16; C.vwo = 2 * KBUF + C.kkey * VST + C.kc * 16;
    u32x4 kA, pA = {0u, 0u, 0u, 0u}, vA;
    AttState<GRP> S;
    S.o0 = (f32x16){}; S.o1 = (f32x16){}; S.mhat = 0.f; S.lrun = 0.f; S.ssq = 0.f; S.refnz = 0;
#pragma unroll
    for (int i = 0; i < 16; ++i) S.pw[i] = 0u;
    { u32x4 kB, pB = {0u, 0u, 0u, 0u};
      att_ldk<GRP>(C, 0, kA, pA); att_ldk<GRP>(C, 1, kB, pB); att_ldv<GRP>(C, 0, vA);
      att_stk<GRP>(C, 0, kA, pA); att_stk<GRP>(C, 1, kB, pB); att_stv<GRP>(C, 0, vA); }
    att_ldk<GRP>(C, 2, kA, pA); att_ldv<GRP>(C, 1, vA);
#pragma unroll
    for (int ks = 0; ks < NKS; ++ks) S.qr[ks] = *(const bf16x8*)(Q + C.qrow * QP + C.h0 * DK + ks * 16 + hi * 8);
    ATT_BAR();
    f32x16 pa0 = {}, pa1 = {}, pb0 = {}, pb1 = {};
    {
        bf16x8 kf[2 * NKS]; att_kfrag<GRP, 0, NKS>(C, 0, kf);
#pragma unroll
        for (int ks = 0; ks < NKS; ++ks) { pa0 = __builtin_amdgcn_mfma_f32_32x32x16_bf16(kf[2 * ks], S.qr[ks], pa0, 0, 0, 0); pa1 = __builtin_amdgcn_mfma_f32_32x32x16_bf16(kf[2 * ks + 1], S.qr[ks], pa1, 0, 0, 0); }
    }
    if (wid >= 4) __builtin_amdgcn_s_setprio(1);
    asm volatile("s_nop 15\n\ts_nop 7" : "+v"(pa0), "+v"(pa1));
    for (int s = 0; s < NSTEP - 2; s += 2) { att_step<GRP, true>(C, S, s, pa0, pa1, pb0, pb1, kA, pA, vA); att_step<GRP, true>(C, S, s + 1, pb0, pb1, pa0, pa1, kA, pA, vA); }
    att_step<GRP, true>(C, S, NSTEP - 2, pa0, pa1, pb0, pb1, kA, pA, vA); att_step<GRP, false>(C, S, NSTEP - 1, pb0, pb1, pa0, pa1, kA, pA, vA);
    __builtin_amdgcn_s_setprio(0);
    const float ssq = xhalf_sum(S.ssq);
    if (hi == 0) RS[C.qrow * 4 + GRP * 2 + hh] = ssq;
    __syncthreads();
}
}

typedef unsigned short bf16;
typedef float f32x4 __attribute__((ext_vector_type(4)));
typedef unsigned v4u __attribute__((ext_vector_type(4)));
typedef unsigned v2u __attribute__((ext_vector_type(2)));
constexpr int M = 32768, SEQ = 4096, D = 1024, DFF = 2816, DIN = 1184, NMOD9 = 9216;
constexpr size_t MiB = 1u << 20;
constexpr size_t WS_MOD = 0, MOD_ZERO_BYTES = 512 * 1024;
constexpr size_t WS_ROPEM = 1 * MiB, WS_ROPEG = 1 * MiB + 65536;
constexpr size_t WS_WGU1 = 2 * MiB, WS_WD1 = 14 * MiB, WS_WGU2 = 20 * MiB, WS_WD2 = 32 * MiB, WS_WIN = 38 * MiB, WS_WUQ = 41 * MiB, WS_WUKV = 42 * MiB, WS_WOUT = 43 * MiB;
constexpr size_t WS_SSQQ = 46 * MiB, WS_SSQKV = 47 * MiB, WS_RSO = 48 * MiB, WS_KPE = 50 * MiB;
constexpr size_t WS_H = 64 * MiB, WS_ACT = 128 * MiB, WS_XR = 304 * MiB;
constexpr size_t WS_QM = 128 * MiB, WS_KN = 176 * MiB, WS_VTM = 208 * MiB, WS_O = 240 * MiB;
constexpr size_t WS_ZQ = 432 * MiB, WS_ZKV = 448 * MiB, WS_QG = 456 * MiB, WS_KG = 488 * MiB, WS_VTG = 496 * MiB, WS_END = 504 * MiB;
constexpr int LDS_BYTES = 131072 + 64, LDS_BARST = 131072;
constexpr size_t WS_BAR = 384 * 1024;

__device__ __forceinline__ unsigned f2bf(float f) { unsigned u = __builtin_bit_cast(unsigned, f); return (u + 0x7fffu + ((u >> 16) & 1u)) >> 16; }
__device__ __forceinline__ unsigned pk2(float lo, float hi) { return f2bf(lo) | (f2bf(hi) << 16); }
#define LDS_WAIT() asm volatile("s_waitcnt lgkmcnt(0)" ::: "memory")
__device__ __forceinline__ float wave_sum(float v) {
#pragma unroll
    for (int o = 1; o < 64; o <<= 1) v += __shfl_xor(v, o);
    return v;
}
struct RmId { __device__ __forceinline__ int operator()(int n) const { return n; } __device__ __forceinline__ float scale(int) const { return 1.0f; } };
struct RmGu { __device__ __forceinline__ int operator()(int n) const { const int up = n >= DFF, j = up ? n - DFF : n; return 256 * (j >> 7) + 128 * up + (j & 127); }
              __device__ __forceinline__ float scale(int n) const { return n >= DFF ? 0.6931471805599453f : 1.4426950408889634f; } };
struct RmWin { __device__ __forceinline__ int operator()(int c) const {
    if (c < 256) return c;
    if (c < 384) return 1024 + (c - 256);
    if (c < 416) { const int d = c - 384, a = d >> 4, p = (d >> 3) & 1, e = d & 7; return 1024 + 128 + 16 * p + 8 * a + e; }
    if (c < 928) { const int h = (c - 416) >> 6, d = (c - 416) & 63; return 256 * (1 + (h >> 2)) + 128 * (d >> 5) + 32 * (h & 3) + (d & 31); }
    if (c < 1056) { const int hk = (c - 928) >> 6, d = (c - 928) & 63; return 768 + 128 * (d >> 5) + 32 * hk + (d & 31); }
    { const int hk = (c - 1056) >> 6, e = (c - 1056) & 63; return 768 + 128 * (e >> 5) + 32 * (2 + hk) + (e & 31); } }  __device__ __forceinline__ float scale(int) const { return 1.0f; } };
struct RmUq { __device__ __forceinline__ int operator()(int c) const { const int h = c / 96, j = c % 96; if (j < 64) return h * 64 + j; const int d = j - 64, a = d >> 4, p = (d >> 3) & 1, e = d & 7; return 512 + 32 * h + 16 * p + 8 * a + e; }  __device__ __forceinline__ float scale(int) const { return 1.0f; } };
struct RmUkv { __device__ __forceinline__ int operator()(int c) const { const int h = c >> 7, j = c & 127; return j < 64 ? h * 64 + j : 512 + h * 64 + (j - 64); }  __device__ __forceinline__ float scale(int) const { return 1.0f; } };

template <class RM> __device__ __forceinline__ void tr_item(const float* __restrict__ W, int K, int N, bf16* __restrict__ WT, RM rm, const float* ks0, const float* ks1, int ksplit, LAS float* scr, int item, int lane) {
    const int nblk = N / 32, kb = item / nblk, nb = item % nblk, k0 = 64 * kb, n0 = 32 * nb;
    f32x4 wv[8];
    const int r8 = lane >> 3, cg = lane & 7;
#pragma unroll
    for (int i = 0; i < 8; ++i) wv[i] = *(const f32x4*)(W + (size_t)(k0 + 8 * i + r8) * N + n0 + 4 * cg);
    const f32x4 cs = {rm.scale(n0 + 4 * cg), rm.scale(n0 + 4 * cg + 1), rm.scale(n0 + 4 * cg + 2), rm.scale(n0 + 4 * cg + 3)};
#pragma unroll
    for (int i = 0; i < 8; ++i) { const int kk = 8 * i + r8; f32x4 w = wv[i] * cs;
        if (ks0) { const int k = k0 + kk; w = w * ((k < ksplit) ? ks0[k] : ks1[k - ksplit]); }
        scr[kk * 33 + 4 * cg] = w[0]; scr[kk * 33 + 4 * cg + 1] = w[1]; scr[kk * 33 + 4 * cg + 2] = w[2]; scr[kk * 33 + 4 * cg + 3] = w[3]; }
    LDS_WAIT(); asm volatile("" ::: "memory");
    const int c = lane & 7;
#pragma unroll
    for (int j = 0; j < 4; ++j) { const int n = (lane >> 3) + 8 * j; const LAS float* s = scr + (8 * c) * 33 + n;
        v4u o; o.x = pk2(s[0 * 33], s[1 * 33]); o.y = pk2(s[2 * 33], s[3 * 33]); o.z = pk2(s[4 * 33], s[5 * 33]); o.w = pk2(s[6 * 33], s[7 * 33]);
        *(v4u*)(WT + (size_t)rm(n0 + n) * K + k0 + 8 * c) = o; }
    LDS_WAIT(); asm volatile("" ::: "memory");
}
__device__ __forceinline__ void mod_item(const float* __restrict__ c, const float* __restrict__ wada, const float* __restrict__ bada, float* MOD, LAS float* scr, int item, int lane) {
    const int cgp = item % 144, kc = item / 144, n = cgp * 64 + lane, k0 = kc * 128;
#pragma unroll
    for (int i = 0; i < 16; ++i) { const int idx = i * 64 + lane, b = idx >> 7, kk = idx & 127; const float v = c[b * D + k0 + kk]; scr[idx] = v / (1.0f + expf(-v)); }
    LDS_WAIT(); asm volatile("" ::: "memory");
    float acc[8];
#pragma unroll
    for (int b = 0; b < 8; ++b) acc[b] = 0.f;
    for (int kq = 0; kq < 128; kq += 32) {
        float wv[32];
#pragma unroll
        for (int i = 0; i < 32; ++i) wv[i] = wada[(size_t)(k0 + kq + i) * NMOD9 + n];
#pragma unroll
        for (int i = 0; i < 32; ++i)
#pragma unroll
            for (int b = 0; b < 8; ++b) acc[b] += scr[b * 128 + kq + i] * wv[i];
    }
    if (kc == 0) { const float bb = bada[n];
#pragma unroll
        for (int b = 0; b < 8; ++b) acc[b] += bb; }
#pragma unroll
    for (int b = 0; b < 8; ++b) atomicAdd(MOD + b * NMOD9 + n, acc[b]);
    LDS_WAIT(); asm volatile("" ::: "memory");
}
template <int MODE, bool XB> __device__ __forceinline__ void norm_pass(const void* __restrict__ X, const float* __restrict__ g, const float* __restrict__ shift, const float* __restrict__ scale,
                                                             bf16* __restrict__ Hb, float* __restrict__ Of, int gw, int NGW, int lane) {
    asm volatile("" : "+v"(lane));
    for (int m0 = gw * 16; m0 < M; m0 += NGW * 16) {
        const int b = m0 / SEQ;
        f32x4 gm[4], sh[4];
#pragma unroll
        for (int j = 0; j < 4; ++j) { const int col = 4 * lane + 256 * j; gm[j] = *(const f32x4*)(g + col);
            if (MODE == 0) { gm[j] = gm[j] * (*(const f32x4*)(scale + (size_t)b * NMOD9 + col) + 1.0f); sh[j] = *(const f32x4*)(shift + (size_t)b * NMOD9 + col); } }
        for (int r = 0; r < 16; ++r) {
            f32x4 v[4]; float s = 0.f;
#pragma unroll
            for (int j = 0; j < 4; ++j) {
                if constexpr (XB) { const v2u w = *(const v2u*)((const bf16*)X + (size_t)(m0 + r) * D + 4 * lane + 256 * j);
                    v[j] = (f32x4){__uint_as_float(w.x << 16), __uint_as_float(w.x & 0xffff0000u), __uint_as_float(w.y << 16), __uint_as_float(w.y & 0xffff0000u)}; }
                else v[j] = *(const f32x4*)((const float*)X + (size_t)(m0 + r) * D + 4 * lane + 256 * j);
                s += (v[j][0] * v[j][0] + v[j][1] * v[j][1]) + (v[j][2] * v[j][2] + v[j][3] * v[j][3]); }
            const float rstd = 1.0f / sqrtf(wave_sum(s) * (1.f / D) + 1e-6f);
#pragma unroll
            for (int j = 0; j < 4; ++j) {
                if (MODE == 0) { const f32x4 o = v[j] * rstd * gm[j] + sh[j]; v2u w; w.x = pk2(o[0], o[1]); w.y = pk2(o[2], o[3]); *(v2u*)(Hb + (size_t)(m0 + r) * D + 4 * lane + 256 * j) = w; }
                else { __builtin_nontemporal_store(v[j] * rstd * gm[j], (f32x4*)(Of + (size_t)(m0 + r) * D + 4 * lane + 256 * j)); }
            }
        }
    }
}

#define XB_TMO      128
#define XB_XCNT(j)  (256  + 64 * (j))
#define XB_XSUB(j)  (1280 + 64 * (j))
#define XB_XGEN(j)  (2304 + 64 * (j))
#define XB_TOP      3328
#define XB_TOPGEN   3392
#define XCD_BAR_WORDS 3456
#define XB_SPIN_CAP (1u << 24)

__device__ __forceinline__ unsigned xb_ld(unsigned* p)              { return __hip_atomic_load(p, __ATOMIC_RELAXED, __HIP_MEMORY_SCOPE_AGENT); }
__device__ __forceinline__ unsigned xb_add(unsigned* p, unsigned v) { return __hip_atomic_fetch_add(p, v, __ATOMIC_RELAXED, __HIP_MEMORY_SCOPE_AGENT); }
__device__ __forceinline__ unsigned xb_xcc_id() { return (unsigned)__builtin_amdgcn_s_getreg((3 << 11) | 20) & 0xFu; }
#define XB_SPIN(cond, bar) do { unsigned _sp = 0; while (cond) { __builtin_amdgcn_s_sleep(1); \
    if ((++_sp & 255u) == 0u) { if (xb_ld(&(bar)[XB_TMO])) break; if (_sp > XB_SPIN_CAP) { atomicAdd(&(bar)[XB_TMO], 1u); break; } } } } while (0)
struct XcdBarrier {
    unsigned* bar; unsigned x;
    volatile LAS unsigned* st;
};

__device__ __forceinline__ XcdBarrier xcd_barrier_post(unsigned* bar, volatile LAS unsigned* st) {
    XcdBarrier b; b.bar = bar; b.x = xb_xcc_id(); b.st = st;
    if (threadIdx.x == 0) (void)xb_add(&bar[XB_XCNT(b.x)], 1u);
    return b;
}
__device__ __forceinline__ void xcd_barrier_complete(unsigned* bar, unsigned x, unsigned& nloc, unsigned& nx) {
    const unsigned G = gridDim.x * gridDim.y * gridDim.z;
    unsigned sum, cnt, mine, sp = 0u;
    for (;;) {
        sum = 0u; cnt = 0u; mine = 0u;
#pragma unroll
        for (unsigned j = 0; j < 16; ++j) { const unsigned c = xb_ld(&bar[XB_XCNT(j)]); sum += c; cnt += (c > 0u) ? 1u : 0u; mine = (j == x) ? c : mine; }
        if (sum == G) break;
        __builtin_amdgcn_s_sleep(1);
        if ((++sp & 255u) == 0u) { if (xb_ld(&bar[XB_TMO])) break; if (sp > XB_SPIN_CAP) { atomicAdd(&bar[XB_TMO], 1u); break; } }
    }
    nloc = mine > 0u ? mine : 1u; nx = cnt > 0u ? cnt : 1u;
}

__device__ __forceinline__ void xcd_barrier(const XcdBarrier& b) {
    asm volatile("s_waitcnt vmcnt(0)" ::: "memory");
    __syncthreads();
    if (threadIdx.x == 0) {
        unsigned* bar = b.bar;
        __builtin_amdgcn_s_waitcnt(0);
        unsigned nloc = b.st[0], nx = b.st[1];
        if (nloc == 0u) { xcd_barrier_complete(bar, b.x, nloc, nx); b.st[0] = nloc; b.st[1] = nx; }
        const unsigned old = xb_add(&bar[XB_XSUB(b.x)], 1u);
        const unsigned gen = old / nloc;
        if (old + 1u == (gen + 1u) * nloc) {
            __builtin_amdgcn_fence(__ATOMIC_RELEASE, "agent");
            asm volatile("s_waitcnt vmcnt(0)" ::: "memory");
            const unsigned og = xb_add(&bar[XB_TOP], 1u);
            const unsigned tg = og / nx;
            if (og + 1u == (tg + 1u) * nx) xb_add(&bar[XB_TOPGEN], 1u);
            else XB_SPIN(xb_ld(&bar[XB_TOPGEN]) == tg, bar);
            __builtin_amdgcn_fence(__ATOMIC_ACQUIRE, "agent");
            xb_add(&bar[XB_XGEN(b.x)], 1u);
            asm volatile("s_waitcnt vmcnt(0)" ::: "memory");
        } else {
            XB_SPIN(xb_ld(&bar[XB_XGEN(b.x)]) == gen, bar);
            __builtin_amdgcn_fence(__ATOMIC_ACQUIRE, "agent");
            asm volatile("s_waitcnt vmcnt(0)" ::: "memory");
        }
    }
    __syncthreads();
}


#ifndef ONLY_PHASE
#define ONLY_PHASE -1
#endif
#define PHON(k) (ONLY_PHASE < 0 || ONLY_PHASE == (k))
struct Args { const float* in[22]; float* out; unsigned char* ws; };
__global__ void __launch_bounds__(512) fwd_megakernel(Args a) {
    extern __shared__ __attribute__((aligned(16))) unsigned char lds_raw[];
    LAS unsigned char* lds = (LAS unsigned char*)lds_raw;
    cg::grid_group grid = cg::this_grid();
    const int tid = threadIdx.x, lane = tid & 63, wave = __builtin_amdgcn_readfirstlane(tid >> 6);
    const int G = gridDim.x, bx = blockIdx.x, gw = bx * 8 + wave, NGW = G * 8;
    const int vgw = (G == 256) ? (((bx & 7) * 32 + (bx >> 3)) * 8 + wave) : gw;
    unsigned char* ws = a.ws;
    float* MOD = (float*)(ws + WS_MOD); float* ROPEM = (float*)(ws + WS_ROPEM); float* ROPEG = (float*)(ws + WS_ROPEG);
    bf16 *WGU1 = (bf16*)(ws + WS_WGU1), *WD1 = (bf16*)(ws + WS_WD1), *WGU2 = (bf16*)(ws + WS_WGU2), *WD2 = (bf16*)(ws + WS_WD2), *WIN = (bf16*)(ws + WS_WIN), *WUQ = (bf16*)(ws + WS_WUQ), *WUKV = (bf16*)(ws + WS_WUKV), *WOUT = (bf16*)(ws + WS_WOUT);
    float *SSQQ = (float*)(ws + WS_SSQQ), *SSQKV = (float*)(ws + WS_SSQKV), *RSO = (float*)(ws + WS_RSO), *XRf_unused = nullptr; bf16* XR = (bf16*)(ws + WS_XR);
    bf16 *KPE = (bf16*)(ws + WS_KPE), *H = (bf16*)(ws + WS_H), *ACT = (bf16*)(ws + WS_ACT), *QM = (bf16*)(ws + WS_QM), *KN = (bf16*)(ws + WS_KN), *VTM = (bf16*)(ws + WS_VTM), *OB = (bf16*)(ws + WS_O);
    bf16 *ZQ = (bf16*)(ws + WS_ZQ), *ZKV = (bf16*)(ws + WS_ZKV), *QG = (bf16*)(ws + WS_QG), *KG = (bf16*)(ws + WS_KG), *VTG = (bf16*)(ws + WS_VTG);
    const float* x = a.in[0];
    if (tid < 16) ((LAS unsigned*)(lds + LDS_BARST))[tid] = 0u;
    __syncthreads();
    const XcdBarrier bar = xcd_barrier_post((unsigned*)(ws + WS_BAR), (volatile LAS unsigned*)(lds + LDS_BARST));

    if constexpr (PHON(0)) {
        LAS float* scr = (LAS float*)(lds + wave * 16384);
        for (int it = gw; it < 1152; it += NGW) mod_item(a.in[1], a.in[2], a.in[3], MOD, scr, it, lane);
        for (int i = bx * 512 + tid; i < 96 * 1024 / 8; i += G * 512) *(v4u*)(WIN + (size_t)1184 * D + (size_t)i * 8) = (v4u){0u, 0u, 0u, 0u};
        for (int i = bx * 512 + tid; i < 64 * 8 + 64 * 16; i += G * 512) {
            if (i < 512) { const int pos = i >> 3, e = i & 7; const float inv = powf(10000.0f, -((float)e * 2.0f / 16.0f)), ang = (float)pos * inv; ROPEM[2 * i] = cosf(ang); ROPEM[2 * i + 1] = sinf(ang); }
            else { const int k = i - 512, pos = k >> 4, f = k & 15; const float inv = powf(10000.0f, -((float)f * 2.0f / 32.0f)), ang = (float)pos * inv; ROPEG[2 * k] = cosf(ang); ROPEG[2 * k + 1] = sinf(ang); }
        }
    }
    grid.sync();
    if constexpr (PHON(1)) norm_pass<0, false>(x, a.in[4], MOD + 0 * D, MOD + 1 * D, H, nullptr, vgw, NGW, lane);
    if constexpr (PHON(0)) {
        LAS float* scr = (LAS float*)(lds + wave * 16384);
        constexpr int I_GU = 16 * 176, I_DN = 44 * 32, I_IN = 16 * 37, I_UQ = 4 * 24, I_UKV = 2 * 32, I_OUT = 16 * 32;
        constexpr int NITEMS = 2 * (I_GU + I_DN) + I_IN + I_UQ + I_UKV + I_OUT;
        for (int it = gw; it < NITEMS; it += NGW) {
            int r = it;
            if (r < I_GU) { tr_item(a.in[5], D, 2 * DFF, WGU1, RmGu{}, nullptr, nullptr, 0, scr, r, lane); continue; } r -= I_GU;
            if (r < I_DN) { tr_item(a.in[6], DFF, D, WD1, RmId{}, nullptr, nullptr, 0, scr, r, lane); continue; } r -= I_DN;
            if (r < I_GU) { tr_item(a.in[19], D, 2 * DFF, WGU2, RmGu{}, nullptr, nullptr, 0, scr, r, lane); continue; } r -= I_GU;
            if (r < I_DN) { tr_item(a.in[20], DFF, D, WD2, RmId{}, nullptr, nullptr, 0, scr, r, lane); continue; } r -= I_DN;
            if (r < I_IN) { tr_item(a.in[8], D, DIN, WIN, RmWin{}, nullptr, nullptr, 0, scr, r, lane); continue; } r -= I_IN;
            if (r < I_UQ) { tr_item(a.in[10], 256, 768, WUQ, RmUq{}, a.in[9], a.in[9], 256, scr, r, lane); continue; } r -= I_UQ;
            if (r < I_UKV) { tr_item(a.in[12], 128, 1024, WUKV, RmUkv{}, a.in[11], a.in[11], 128, scr, r, lane); continue; } r -= I_UKV;
            tr_item(a.in[17], D, D, WOUT, RmId{}, a.in[15], a.in[16], 512, scr, r, lane);
        }
    }
    xcd_barrier(bar);
    if constexpr (PHON(2)) { pg8::Gemm g{H, WGU1, M, 2 * DFF, D}; pg8::StaticOrder S; S.init(M, 2 * DFF, G, bx); pg8::EpiSwiglu E{ACT}; pg8::gemm_phase<pg8::EpiSwiglu, pg8::StaticOrder, true, true>(lds, g, S, E); }
    xcd_barrier(bar);
    if constexpr (PHON(3)) { pg8::Gemm g{ACT, WD1, M, D, DFF}; pg8::StaticOrder S; S.init(M, D, G, bx); pg8::EpiResid<false, true> E{x, XR, MOD + 2 * D, nullptr}; pg8::gemm_phase<pg8::EpiResid<false, true>, pg8::StaticOrder, true, true>(lds, g, S, E); }
    xcd_barrier(bar);
    if constexpr (PHON(1)) norm_pass<0, true>(XR, a.in[7], MOD + 3 * D, MOD + 4 * D, H, nullptr, vgw, NGW, lane);
    xcd_barrier(bar);
    if constexpr (PHON(5)) { pg8::Gemm g{H, WIN, M, 1280, D}; pg8::StaticOrder S; S.init(M, 1280, G, bx); pg8::EpiWin E{ZQ, ZKV, KPE, QG, KG, VTG, SSQQ, SSQKV, a.in[13], a.in[14], ROPEM, ROPEG};
      pg8::gemm_phase<pg8::EpiWin, pg8::StaticOrder, true, true>(lds, g, S, E); }
    xcd_barrier(bar);
    if constexpr (PHON(6)) { pg8::Gemm g{ZQ, WUQ, M, 768, 256}; pg8::StaticOrder S; S.init(M, 768, G, bx); pg8::EpiUq E{QM, SSQQ, ROPEM}; pg8::gemm_phase<pg8::EpiUq, pg8::StaticOrder, true, true>(lds, g, S, E); }
    __syncthreads();
    if constexpr (PHON(7)) { pg8::Gemm g{ZKV, WUKV, M, 1024, 128}; pg8::StaticOrder S; S.init(M, 1024, G, bx); pg8::EpiUkv E{KN, VTM, SSQKV}; pg8::gemm_phase<pg8::EpiUkv, pg8::StaticOrder, true, true>(lds, g, S, E); }
    xcd_barrier(bar);
    if constexpr (PHON(8)) for (int u = bx; u < 256; u += G) {
        const int b = u & 7, idx = u >> 3, qb = idx & 15, hh = idx >> 4;
        att::attn_unit<0>(lds, b, qb, hh, QM, KN, KPE, VTM, OB, RSO);
        att::attn_unit<1>(lds, b, qb, hh, QG, KG, KPE, VTG, OB, RSO);
    }
    xcd_barrier(bar);
    if constexpr (PHON(9)) { pg8::Gemm g{OB, WOUT, M, D, D}; pg8::StaticOrder S; S.init(M, D, G, bx); pg8::EpiResid<true, false> E{XR, XR, MOD + 5 * D, RSO}; pg8::gemm_phase<pg8::EpiResid<true, false>, pg8::StaticOrder, true, true>(lds, g, S, E); }
    xcd_barrier(bar);
    if constexpr (PHON(1)) norm_pass<0, true>(XR, a.in[18], MOD + 6 * D, MOD + 7 * D, H, nullptr, vgw, NGW, lane);
    xcd_barrier(bar);
    if constexpr (PHON(2)) { pg8::Gemm g{H, WGU2, M, 2 * DFF, D}; pg8::StaticOrder S; S.init(M, 2 * DFF, G, bx); pg8::EpiSwiglu E{ACT}; pg8::gemm_phase<pg8::EpiSwiglu, pg8::StaticOrder, true, true>(lds, g, S, E); }
    xcd_barrier(bar);
    if constexpr (PHON(3)) { pg8::Gemm g{ACT, WD2, M, D, DFF}; pg8::StaticOrder S; S.init(M, D, G, bx); pg8::EpiResid<false, false> E{XR, XR, MOD + 8 * D, nullptr}; pg8::gemm_phase<pg8::EpiResid<false, false>, pg8::StaticOrder, true, true>(lds, g, S, E); }
    xcd_barrier(bar);
    if constexpr (PHON(1)) norm_pass<1, true>(XR, a.in[21], nullptr, nullptr, nullptr, a.out, vgw, NGW, lane);
}

extern "C" void kernel_launch(void* const* d_in, const int* in_sizes, int n_in, void* d_out, int out_size, void* d_ws, size_t ws_size, hipStream_t stream) {
    static int grid_blocks = 0;
    if (grid_blocks == 0) {
        if (n_in != 22 || out_size != M * D || ws_size < WS_END) { fprintf(stderr, "kernel_launch: unexpected shapes (n_in %d, out %d, ws %zu)\n", n_in, out_size, ws_size); grid_blocks = -1; return; }
        int dev = 0, cus = 0, per_cu = 0;
        hipGetDevice(&dev);
        hipDeviceGetAttribute(&cus, hipDeviceAttributeMultiprocessorCount, dev);
        if (hipFuncSetAttribute((const void*)fwd_megakernel, hipFuncAttributeMaxDynamicSharedMemorySize, LDS_BYTES) != hipSuccess) { fprintf(stderr, "kernel_launch: hipFuncSetAttribute failed\n"); grid_blocks = -1; return; }
        if (hipOccupancyMaxActiveBlocksPerMultiprocessor(&per_cu, (const void*)fwd_megakernel, 512, LDS_BYTES) != hipSuccess || per_cu < 1) { fprintf(stderr, "kernel_launch: occupancy query gave %d\n", per_cu); per_cu = 1; }
        (void)hipGetLastError();
        grid_blocks = cus * per_cu;
    }
    if (grid_blocks < 0) return;
    hipMemsetAsync((char*)d_ws + WS_MOD, 0, MOD_ZERO_BYTES, stream);
    Args a{};
    for (int i = 0; i < 22; ++i) a.in[i] = (const float*)d_in[i];
    a.out = (float*)d_out; a.ws = (unsigned char*)d_ws;
    void* args[] = {&a};
    hipError_t e = hipLaunchCooperativeKernel((const void*)fwd_megakernel, dim3(grid_blocks), dim3(512), args, LDS_BYTES, stream);
    if (e != hipSuccess) fprintf(stderr, "cooperative launch failed: %s (grid %d)\n", hipGetErrorString(e), grid_blocks);
}
```
